# Optimizing an MI355X kernel written in HIP

```python
import math
import jax, jax.numpy as jnp
from jax import lax
import numpy as np

D_MODEL = 1024
BATCH = 2
SEQ = 8192
DEPTH = 1

HEAD_DIM = 64
SWA_Q_HEADS = 8
SWA_KV_HEADS = 2
SWA_GROUP = SWA_Q_HEADS // SWA_KV_HEADS
WINDOW = 128
DIFF_HEADS = 4
DIFF_V_DIM = 2 * HEAD_DIM
MIX_A_WIDTH = SWA_Q_HEADS * HEAD_DIM
MIX_B_WIDTH = DIFF_HEADS * DIFF_V_DIM
MIX_WIDTH = MIX_A_WIDTH + MIX_B_WIDTH
A_Q = SWA_Q_HEADS * HEAD_DIM
A_K = SWA_KV_HEADS * HEAD_DIM
A_V = SWA_KV_HEADS * HEAD_DIM
B_Q = DIFF_HEADS * 2 * HEAD_DIM
B_K = DIFF_HEADS * 2 * HEAD_DIM
B_V = DIFF_HEADS * DIFF_V_DIM
IN_COLS = A_Q + A_K + A_V + B_Q + B_K + B_V
IN_SPLITS = [int(v) for v in np.cumsum([A_Q, A_K, A_V, B_Q, B_K])]
Q_BLOCK = 128
ROPE_THETA = 10000.0
N_EXPERTS = 32
TOP_K = 4
D_FF = D_MODEL
SWIGLU_ALPHA = 1.702
SWIGLU_LIMIT = 7.0
EXPERT_BLOCK = 128
EPS = 1e-5
N_MOD = 6

kernel_name = "hymba_swa_sink_diffattn_moe_adaln"


def rms_norm(x, g):
    xf = x.astype(jnp.float32)
    y = xf * lax.rsqrt(jnp.mean(xf * xf, axis=-1, keepdims=True) + EPS)
    return (y * g.astype(jnp.float32)).astype(x.dtype)


def modulate(h, shift, scale):
    return h * (1 + scale[:, None, :]) + shift[:, None, :]


def rope_tables(positions):
    inv = 1.0 / (ROPE_THETA ** (jnp.arange(0, HEAD_DIM, 2, dtype=jnp.float32) / HEAD_DIM))
    ang = positions.astype(jnp.float32)[..., None] * inv
    return jnp.cos(ang)[:, :, None, :], jnp.sin(ang)[:, :, None, :]


def apply_rope(t, cos, sin):
    tf = t.astype(jnp.float32)
    t1, t2 = jnp.split(tf, 2, axis=-1)
    out = jnp.concatenate([t1 * cos - t2 * sin, t2 * cos + t1 * sin], axis=-1)
    return out.astype(t.dtype)


def sliding_window_sink_attention(q, k, v, sinks):
    B, S, _, D = q.shape
    nb = S // WINDOW
    qb = q.reshape(B, nb, WINDOW, SWA_KV_HEADS, SWA_GROUP, D)

    def with_prev(t):
        tb = t.reshape(B, nb, WINDOW, SWA_KV_HEADS, D)
        prev = jnp.pad(tb, ((0, 0), (1, 0), (0, 0), (0, 0), (0, 0)))[:, :-1]
        return jnp.concatenate([prev, tb], axis=2)

    kb, vb = with_prev(k), with_prev(v)
    s = jnp.einsum('bnikgd,bnjkd->bnkgij', qb, kb,
                   preferred_element_type=jnp.float32) / math.sqrt(D)
    qi = jnp.arange(WINDOW) + WINDOW
    kj = jnp.arange(2 * WINDOW)
    diff = qi[:, None] - kj[None, :]
    band = (diff >= 0) & (diff < WINDOW)
    blk = jnp.arange(nb)[:, None, None]
    mask = band[None] & ((blk > 0) | (kj[None, None, :] >= WINDOW))
    s = jnp.where(mask[None, :, None, None], s, -jnp.inf)
    sink = sinks.astype(jnp.float32).reshape(SWA_KV_HEADS, SWA_GROUP)[None, None, :, :, None, None]
    m = jnp.maximum(jnp.max(s, axis=-1, keepdims=True), sink)
    p = jnp.exp(s - m)
    p = p / (jnp.sum(p, axis=-1, keepdims=True) + jnp.exp(sink - m))
    o = jnp.einsum('bnkgij,bnjkd->bnikgd', p.astype(v.dtype), vb)
    return o.reshape(B, S, SWA_Q_HEADS * D)


def differential_attention(q, k, v, lam, g_subln, lambda_init):
    B, S, H, _, D = q.shape
    nb = S // Q_BLOCK
    qb = jnp.moveaxis(q.reshape(B, nb, Q_BLOCK, H, 2, D), 1, 0)
    kpos = jnp.arange(S)
    scale = 1.0 / math.sqrt(D)

    def block(args):
        qblk, start = args
        s = jnp.einsum('bihmd,bjhmd->bhmij', qblk, k,
                       preferred_element_type=jnp.float32) * scale
        qpos = start + jnp.arange(Q_BLOCK)
        causal = kpos[None, :] <= qpos[:, None]
        p = jax.nn.softmax(jnp.where(causal, s, -jnp.inf), axis=-1)
        a = p[:, :, 0] - lam * p[:, :, 1]
        return jnp.einsum('bhij,bjhe->bihe', a.astype(v.dtype), v)

    o = lax.map(block, (qb, jnp.arange(nb) * Q_BLOCK))
    o = jnp.moveaxis(o, 0, 1).reshape(B, S, H, DIFF_V_DIM)
    o = rms_norm(o, g_subln) * (1.0 - lambda_init)
    return o.reshape(B, S, H * DIFF_V_DIM)


def swiglu_clamped(u):
    x_glu = jnp.minimum(u[..., ::2], SWIGLU_LIMIT)
    x_lin = jnp.clip(u[..., 1::2], -SWIGLU_LIMIT, SWIGLU_LIMIT)
    return x_glu * jax.nn.sigmoid(SWIGLU_ALPHA * x_glu) * (x_lin + 1)


def moe_ffn(h, w_router, b_router, w1, b1, w2, b2):
    B, S, D = h.shape
    N = B * S
    hf = h.reshape(N, D)
    logits = (hf @ w_router + b_router).astype(jnp.float32)
    top_val, top_idx = lax.top_k(logits, TOP_K)
    gate = jax.nn.softmax(top_val, axis=-1)
    flat_e = top_idx.reshape(-1)
    flat_tok = jnp.repeat(jnp.arange(N, dtype=jnp.int32), TOP_K)
    flat_w = gate.reshape(-1)
    order = jnp.argsort(flat_e)
    e_sorted, tok_sorted, w_sorted = flat_e[order], flat_tok[order], flat_w[order]
    counts = jnp.bincount(flat_e, length=N_EXPERTS)
    padded = (counts + EXPERT_BLOCK - 1) // EXPERT_BLOCK * EXPERT_BLOCK
    starts = jnp.cumsum(counts) - counts
    pends = jnp.cumsum(padded)
    pstarts = pends - padded
    dest = pstarts[e_sorted] + (jnp.arange(N * TOP_K) - starts[e_sorted])
    n_rows = (N * TOP_K + N_EXPERTS * (EXPERT_BLOCK - 1) + EXPERT_BLOCK - 1) // EXPERT_BLOCK * EXPERT_BLOCK
    n_blocks = n_rows // EXPERT_BLOCK
    row_tok = jnp.full((n_rows,), N, jnp.int32).at[dest].set(tok_sorted)
    row_w = jnp.zeros((n_rows,), jnp.float32).at[dest].set(w_sorted)
    block_e = jnp.clip(jnp.searchsorted(pends, jnp.arange(n_blocks) * EXPERT_BLOCK, side='right'),
                       0, N_EXPERTS - 1)
    x_rows = jnp.concatenate([hf, jnp.zeros((1, D), hf.dtype)], axis=0)[row_tok]
    x_rows = x_rows.reshape(n_blocks, EXPERT_BLOCK, D)

    def expert_block(args):
        xb, e = args
        u = xb @ w1[e] + b1[e]
        return swiglu_clamped(u) @ w2[e] + b2[e]

    y = lax.map(expert_block, (x_rows, block_e)).reshape(n_rows, D)
    y = y * row_w[:, None].astype(y.dtype)
    out = jax.ops.segment_sum(y, row_tok, num_segments=N + 1)[:N]
    return out.reshape(B, S, D)


def setup_inputs(seed: int = 0) -> dict:
    key = jax.random.key(seed)
    ks = jax.random.split(key, 26)
    nrm = lambda k, shape: jax.random.normal(k, shape, jnp.float32)
    L, D = DEPTH, D_MODEL
    offsets = jax.random.randint(ks[2], (BATCH, 1), 0, 4096, dtype=jnp.int32)
    positions = offsets + jnp.arange(SEQ, dtype=jnp.int32)[None, :]
    return {
        "x": nrm(ks[0], (BATCH, SEQ, D)),
        "c": nrm(ks[1], (BATCH, D)),
        "positions": positions,
        "w_ada": nrm(ks[3], (L, D, N_MOD * D)) * (0.5 * D ** -0.5),
        "b_ada": nrm(ks[4], (L, N_MOD * D)) * 0.02,
        "g_mix": 1.0 + 0.02 * nrm(ks[5], (L, D)),
        "w_in": nrm(ks[6], (L, D, IN_COLS)) * D ** -0.5,
        "b_in": nrm(ks[7], (L, IN_COLS)) * 0.02,
        "attn_sinks": nrm(ks[8], (L, SWA_Q_HEADS)) * 0.5,
        "lambda_q1": nrm(ks[9], (L, HEAD_DIM)) * 0.1,
        "lambda_k1": nrm(ks[10], (L, HEAD_DIM)) * 0.1,
        "lambda_q2": nrm(ks[11], (L, HEAD_DIM)) * 0.1,
        "lambda_k2": nrm(ks[12], (L, HEAD_DIM)) * 0.1,
        "g_subln": 1.0 + 0.02 * nrm(ks[13], (L, DIFF_V_DIM)),
        "w_out": nrm(ks[14], (L, MIX_WIDTH, D)) * MIX_WIDTH ** -0.5,
        "b_out": nrm(ks[15], (L, D)) * 0.02,
        "g_ffn": 1.0 + 0.02 * nrm(ks[16], (L, D)),
        "w_router": nrm(ks[17], (L, D, N_EXPERTS)) * D ** -0.5,
        "b_router": nrm(ks[18], (L, N_EXPERTS)) * 0.01,
        "w1": nrm(ks[19], (L, N_EXPERTS, D, 2 * D_FF)) * D ** -0.5,
        "b1": nrm(ks[20], (L, N_EXPERTS, 2 * D_FF)) * 0.02,
        "w2": nrm(ks[21], (L, N_EXPERTS, D_FF, D)) * D_FF ** -0.5,
        "b2": nrm(ks[22], (L, N_EXPERTS, D)) * 0.02,
        "g_final": 1.0 + 0.02 * nrm(ks[23], (D,)),
    }


def reference(x, c, positions, w_ada, b_ada, g_mix, w_in, b_in, attn_sinks,
              lambda_q1, lambda_k1, lambda_q2, lambda_k2, g_subln, w_out, b_out,
              g_ffn, w_router, b_router, w1, b1, w2, b2, g_final):
    B, S, D = x.shape
    cos, sin = rope_tables(positions)
    cond = jax.nn.silu(c)
    for layer in range(DEPTH):
        mod = cond @ w_ada[layer] + b_ada[layer]
        sh1, sc1, gt1, sh2, sc2, gt2 = jnp.split(mod, N_MOD, axis=-1)

        h = modulate(rms_norm(x, g_mix[layer]), sh1, sc1)
        proj = h @ w_in[layer] + b_in[layer]
        qa, ka, va, qd, kd, vd = jnp.split(proj, IN_SPLITS, axis=-1)
        qa = apply_rope(qa.reshape(B, S, SWA_Q_HEADS, HEAD_DIM), cos, sin)
        ka = apply_rope(ka.reshape(B, S, SWA_KV_HEADS, HEAD_DIM), cos, sin)
        va = va.reshape(B, S, SWA_KV_HEADS, HEAD_DIM)
        out_a = sliding_window_sink_attention(qa, ka, va, attn_sinks[layer])
        qd = apply_rope(qd.reshape(B, S, DIFF_HEADS * 2, HEAD_DIM), cos, sin)
        kd = apply_rope(kd.reshape(B, S, DIFF_HEADS * 2, HEAD_DIM), cos, sin)
        qd = qd.reshape(B, S, DIFF_HEADS, 2, HEAD_DIM)
        kd = kd.reshape(B, S, DIFF_HEADS, 2, HEAD_DIM)
        vd = vd.reshape(B, S, DIFF_HEADS, DIFF_V_DIM)
        lambda_init = 0.8 - 0.6 * math.exp(-0.3 * layer)
        lam = (jnp.exp(jnp.sum(lambda_q1[layer].astype(jnp.float32) * lambda_k1[layer].astype(jnp.float32)))
               - jnp.exp(jnp.sum(lambda_q2[layer].astype(jnp.float32) * lambda_k2[layer].astype(jnp.float32)))
               + lambda_init)
        out_b = differential_attention(qd, kd, vd, lam, g_subln[layer], lambda_init)
        mixed = jnp.concatenate([out_a, out_b], axis=-1)
        x = x + gt1[:, None, :] * (mixed @ w_out[layer] + b_out[layer])

        h = modulate(rms_norm(x, g_ffn[layer]), sh2, sc2)
        x = x + gt2[:, None, :] * moe_ffn(h, w_router[layer], b_router[layer],
                                          w1[layer], b1[layer], w2[layer], b2[layer])
    return rms_norm(x, g_final)
```

```cpp
#include <hip/hip_runtime.h>
#include <cstdint>
#include <cstdio>

constexpr int BATCH = 2, SEQ = 8192, NTOK = BATCH * SEQ, DM = 1024, NPROJ = 2304, NEXP = 32, TOPK = 4, DFF = 1024, NMOD = 6;
constexpr float EPS = 1e-5f;
constexpr float C2 = 0.125f * 1.4426950408889634f;
constexpr float LOG2E = 1.4426950408889634f;
constexpr float LAMBDA_INIT = 0.2f;
constexpr int PC_QA = 0, PC_KA = 512, PC_QD = 640, PC_KD = 1152, PC_VA = 1664, PC_VD = 1792, PC_ROPE_END = 1664;
constexpr int MAXTILES = 288;
constexpr int MAXROWS = MAXTILES * 256;

constexpr size_t MiB = 1u << 20;
constexpr size_t WS_CTL = 0, CTL_ZERO_BYTES = 64 * 1024;
constexpr size_t WS_MOD = 1 * MiB;
constexpr size_t WS_BINP = WS_MOD + 64 * 1024;
constexpr size_t WS_LAM = WS_BINP + 16 * 1024;
constexpr size_t WS_TILES = WS_LAM + 1024;
constexpr size_t WS_ROPE = 2 * MiB;
constexpr size_t WS_WIN = 8 * MiB;
constexpr size_t WS_WOUT = 14 * MiB;
constexpr size_t WS_W1 = 16 * MiB;
constexpr size_t WS_W2 = 144 * MiB;
constexpr size_t WS_H1 = 208 * MiB;
constexpr size_t WS_PROJ = 240 * MiB;
constexpr size_t WS_OV = 312 * MiB;
constexpr size_t WS_MIXED = 344 * MiB;
constexpr size_t WS_X1 = 376 * MiB;
constexpr size_t WS_H2 = 440 * MiB;
constexpr size_t WS_GATE = 474 * MiB;
constexpr size_t WS_TOKPOS = WS_GATE + 256 * 1024;
constexpr size_t WS_LIST = 475 * MiB;
constexpr size_t WS_ROWMAP = 478 * MiB;
constexpr size_t WS_ACT = 480 * MiB;
constexpr size_t WS_Y = 624 * MiB;
constexpr size_t WS_END = 768 * MiB;
constexpr int CW_CNT = 64;

__constant__ float ROPE_INV[32] = {
    1.000000000e+00f, 7.498942018e-01f, 5.623413324e-01f, 4.216965139e-01f, 3.162277639e-01f, 2.371373922e-01f, 1.778279394e-01f, 1.333521456e-01f,
    1.000000015e-01f, 7.498941571e-02f, 5.623412877e-02f, 4.216964915e-02f, 3.162277862e-02f, 2.371373586e-02f, 1.778279431e-02f, 1.333521493e-02f,
    9.999999776e-03f, 7.498942316e-03f, 5.623413250e-03f, 4.216964822e-03f, 3.162277862e-03f, 2.371373819e-03f, 1.778279431e-03f, 1.333521446e-03f,
    1.000000047e-03f, 7.498941850e-04f, 5.623413017e-04f, 4.216965463e-04f, 3.162277862e-04f, 2.371373848e-04f, 1.778279402e-04f, 1.333521504e-04f};
typedef unsigned short bf16_t;
typedef float f32x4 __attribute__((ext_vector_type(4)));
typedef short bf16x8 __attribute__((ext_vector_type(8)));
typedef unsigned u32x4 __attribute__((ext_vector_type(4)));
typedef unsigned u32x2 __attribute__((ext_vector_type(2)));

__device__ __forceinline__ unsigned f2bf(float f) { unsigned u = __float_as_uint(f); return (u + 0x7fffu + ((u >> 16) & 1u)) >> 16; }
__device__ __forceinline__ unsigned pk2(float lo, float hi) { return f2bf(lo) | (f2bf(hi) << 16); }
__device__ __forceinline__ float bf2f(unsigned h) { return __uint_as_float(h << 16); }
__device__ __forceinline__ float bflo(unsigned w) { return __uint_as_float(w << 16); }
__device__ __forceinline__ float bfhi(unsigned w) { return __uint_as_float(w & 0xffff0000u); }
__device__ __forceinline__ float wave_sum(float v) {
#pragma unroll
    for (int o = 1; o < 64; o <<= 1) v += __shfl_xor(v, o);
    return v;
}

struct Params {
    const float *x, *c; const int* pos; const float *w_ada, *b_ada, *g_mix, *w_in, *b_in, *sinks, *lq1, *lk1, *lq2, *lk2, *g_subln, *w_out, *b_out, *g_ffn,
        *w_router, *b_router, *w1, *b1, *w2, *b2, *g_final;
    float* out; unsigned char* ws;
};

__device__ __forceinline__ int proj_col_of_src(int s) {
    if (s < 640) { const int head = s >> 6, d = s & 63; return head * 64 + 2 * (d & 31) + (d >> 5); }
    if (s < 768) return PC_VA + (s - 640);
    if (s < 1792) { const int t = s - 768, head = t >> 6, d = t & 63; return PC_QD + head * 64 + 2 * (d & 31) + (d >> 5); }
    return s;
}

template <bool PERMUTE>
__device__ __forceinline__ void transpose_item(const float* __restrict__ W, int K, int N, bf16_t* __restrict__ WT, int item, int lane) {
    const int nblk = N / 32, kb = item / nblk, nb = item % nblk;
    const int k0 = 64 * kb + 8 * (lane >> 3), n0 = 32 * nb + 4 * (lane & 7);
    f32x4 v[8];
#pragma unroll
    for (int kk = 0; kk < 8; ++kk) v[kk] = *(const f32x4*)(W + (size_t)(k0 + kk) * N + n0);
#pragma unroll
    for (int i = 0; i < 4; ++i) {
        const int r = PERMUTE ? proj_col_of_src(n0 + i) : (n0 + i);
        u32x4 o; o.x = pk2(v[0][i], v[1][i]); o.y = pk2(v[2][i], v[3][i]); o.z = pk2(v[4][i], v[5][i]); o.w = pk2(v[6][i], v[7][i]);
        *(u32x4*)(WT + (size_t)r * K + k0) = o;
    }
}

__device__ __forceinline__ void sincos_acc(float angf, float& s, float& c) {
    const double a = (double)angf;
    const double n = __builtin_rint(a * 0.63661977236758134308);
    double r = __builtin_fma(-n, 1.57079632679489655800e+00, a);
    r = __builtin_fma(-n, 6.12323399573676603587e-17, r);
    const double r2 = r * r;
    double sp = -2.5052108385441718775e-08; sp = sp * r2 + 2.7557319223985890653e-06; sp = sp * r2 - 1.9841269841269841253e-04; sp = sp * r2 + 8.3333333333333332177e-03;
    sp = sp * r2 - 1.6666666666666665741e-01; const double sn = r + r * r2 * sp;
    double cp = 2.0876756987868098979e-09; cp = cp * r2 - 2.7557319223985888276e-07; cp = cp * r2 + 2.4801587301587301566e-05; cp = cp * r2 - 1.3888888888888889419e-03;
    cp = cp * r2 + 4.1666666666666664354e-02; const double cs = 1.0 - 0.5 * r2 + r2 * r2 * cp;
    const int q = ((int)n) & 3;
    const double ss = (q & 1) ? cs : sn, cc = (q & 1) ? sn : cs;
    s = (float)((q & 2) ? -ss : ss); c = (float)(((q + 1) & 2) ? -cc : cc);
}

__device__ __forceinline__ void phase_prep(const Params& p, int bid, int nb, float* lds) {
    const int tid = threadIdx.x, lane = tid & 63, wave = tid >> 6;
    unsigned char* ws = p.ws;
    for (int jc = bid; jc < NMOD * DM / 64; jc += nb) {
        const int j = jc * 64 + lane; float a0 = 0.f, a1 = 0.f;
        for (int k = wave * 128; k < wave * 128 + 128; ++k) {
            const float c0 = p.c[k], c1 = p.c[DM + k];
            const float s0 = c0 / (1.f + __expf(-c0)), s1 = c1 / (1.f + __expf(-c1));
            const float w = p.w_ada[(size_t)k * (NMOD * DM) + j];
            a0 += s0 * w; a1 += s1 * w;
        }
        lds[(wave * 2 + 0) * 64 + lane] = a0; lds[(wave * 2 + 1) * 64 + lane] = a1;
        __syncthreads();
        if (wave < 2) { float s = 0.f;
#pragma unroll
            for (int w = 0; w < 8; ++w) s += lds[(w * 2 + wave) * 64 + lane];
            ((float*)(ws + WS_MOD))[wave * (NMOD * DM) + j] = s + p.b_ada[j]; }
        __syncthreads();
    }
    { float* ct = (float*)(ws + WS_ROPE); float* st = ct + (size_t)NTOK * 32;
        for (int i = bid * 512 + tid; i < NTOK * 32; i += nb * 512) {
            const int row = i >> 5, f = i & 31;
            const float ang = (float)p.pos[row] * ROPE_INV[f];
            float s, c; sincos_acc(ang, s, c); ct[i] = c; st[i] = s; } }
    if (bid == nb - 1) {
        float* bp = (float*)(ws + WS_BINP);
        for (int s = tid; s < NPROJ; s += 512) bp[proj_col_of_src(s)] = p.b_in[s];
        if (wave == 0) { const float a = wave_sum(p.lq1[lane] * p.lk1[lane]), b = wave_sum(p.lq2[lane] * p.lk2[lane]);
            if (lane == 0) *(float*)(ws + WS_LAM) = expf(a) - expf(b) + LAMBDA_INIT; }
    }
    const int gw = bid * 8 + wave, NGW = nb * 8;
    constexpr int I_IN = (DM / 64) * (NPROJ / 32), I_OUT = (DM / 64) * (DM / 32), I_W1 = (DM / 64) * (2 * DFF / 32), I_W2 = (DFF / 64) * (DM / 32);
    constexpr int NITEMS = I_IN + I_OUT + NEXP * I_W1 + NEXP * I_W2;
    for (int it = gw; it < NITEMS; it += NGW) {
        int r = it;
        if (r < I_IN) { transpose_item<true>(p.w_in, DM, NPROJ, (bf16_t*)(ws + WS_WIN), r, lane); continue; } r -= I_IN;
        if (r < I_OUT) { transpose_item<false>(p.w_out, DM, DM, (bf16_t*)(ws + WS_WOUT), r, lane); continue; } r -= I_OUT;
        if (r < NEXP * I_W1) { const int e = r / I_W1; transpose_item<false>(p.w1 + (size_t)e * DM * 2 * DFF, DM, 2 * DFF, (bf16_t*)(ws + WS_W1) + (size_t)e * 2 * DFF * DM, r % I_W1, lane); continue; } r -= NEXP * I_W1;
        { const int e = r / I_W2; transpose_item<false>(p.w2 + (size_t)e * DFF * DM, DFF, DM, (bf16_t*)(ws + WS_W2) + (size_t)e * DM * DFF, r % I_W2, lane); }
    }
}

__device__ __forceinline__ void norm_mod_row(const float* xrow, const float* g, const float* sc, const float* sh, bf16_t* orow, int lane) {
    f32x4 v[4]; float s = 0.f;
#pragma unroll
    for (int j = 0; j < 4; ++j) { v[j] = *(const f32x4*)(xrow + 4 * lane + 256 * j); s += (v[j].x * v[j].x + v[j].y * v[j].y) + (v[j].z * v[j].z + v[j].w * v[j].w); }
    const float rinv = 1.0f / sqrtf(wave_sum(s) * (1.f / DM) + EPS);
#pragma unroll
    for (int j = 0; j < 4; ++j) {
        const f32x4 gg = *(const f32x4*)(g + 4 * lane + 256 * j), cc = *(const f32x4*)(sc + 4 * lane + 256 * j), hh = *(const f32x4*)(sh + 4 * lane + 256 * j);
        const f32x4 o = v[j] * rinv * gg * (1.0f + cc) + hh;
        u32x2 w; w.x = pk2(o.x, o.y); w.y = pk2(o.z, o.w);
        *(u32x2*)(orow + 4 * lane + 256 * j) = w;
    }
}
__device__ __forceinline__ void phase_h1(const Params& p, int bid, int nb) {
    const int lane = threadIdx.x & 63, wave = threadIdx.x >> 6, gw = bid * 8 + wave, NGW = nb * 8;
    const float* mod = (const float*)(p.ws + WS_MOD);
    for (int m = gw; m < NTOK; m += NGW) { const int b = m / SEQ;
        norm_mod_row(p.x + (size_t)m * DM, p.g_mix, mod + b * (NMOD * DM) + 1 * DM, mod + b * (NMOD * DM) + 0 * DM, (bf16_t*)(p.ws + WS_H1) + (size_t)m * DM, lane); }
}

__device__ __forceinline__ void phase_combine(const Params& p, int bid, int nb) {
    const int lane = threadIdx.x & 63, wave = threadIdx.x >> 6, gw = bid * 8 + wave, NGW = nb * 8;
    const float lam = *(const float*)(p.ws + WS_LAM);
    const int h = lane >> 4, e0 = (lane & 15) * 8, half = e0 >> 6, d0 = e0 & 63;
    float g[8];
#pragma unroll
    for (int i = 0; i < 8; ++i) g[i] = p.g_subln[e0 + i] * (1.0f - LAMBDA_INIT);
    for (int m = gw; m < NTOK; m += NGW) {
        const bf16_t* ov = (const bf16_t*)(p.ws + WS_OV) + (size_t)m * DM;
        const u32x4 a = *(const u32x4*)(ov + ((h * 2 + 0) * 2 + half) * 64 + d0), b = *(const u32x4*)(ov + ((h * 2 + 1) * 2 + half) * 64 + d0);
        float o[8]; float s = 0.f;
#pragma unroll
        for (int i = 0; i < 4; ++i) { o[2 * i] = bflo(a[i]) - lam * bflo(b[i]); o[2 * i + 1] = bfhi(a[i]) - lam * bfhi(b[i]); }
#pragma unroll
        for (int i = 0; i < 8; ++i) s += o[i] * o[i];
        s += __shfl_xor(s, 1); s += __shfl_xor(s, 2); s += __shfl_xor(s, 4); s += __shfl_xor(s, 8);
        const float rinv = 1.0f / sqrtf(s * (1.f / 128.f) + EPS);
        u32x4 w; w.x = pk2(o[0] * rinv * g[0], o[1] * rinv * g[1]); w.y = pk2(o[2] * rinv * g[2], o[3] * rinv * g[3]);
        w.z = pk2(o[4] * rinv * g[4], o[5] * rinv * g[5]); w.w = pk2(o[6] * rinv * g[6], o[7] * rinv * g[7]);
        *(u32x4*)((bf16_t*)(p.ws + WS_MIXED) + (size_t)m * DM + 512 + h * 128 + e0) = w;
    }
}

constexpr int ROUTER_LDS = 131072 + 4096;
__device__ __forceinline__ void phase_router(const Params& p, int bid, int nb, unsigned char* ldsb) {
    const int tid = threadIdx.x, lane = tid & 63, wave = tid >> 6;
    float* wrT = (float*)ldsb; int* hist = (int*)(ldsb + 131072); int* gbase = hist + 32; int* rec = hist + 64;
    unsigned* cnt = (unsigned*)(p.ws + WS_CTL) + CW_CNT;
    for (int i = tid; i < DM * NEXP; i += 512) { const int k = i >> 5, e = i & 31; wrT[e * DM + k] = p.w_router[i]; }
    __syncthreads();
    const float* mod = (const float*)(p.ws + WS_MOD);
    for (int r0 = bid * 64; r0 < NTOK; r0 += nb * 64) {
        if (tid < 32) hist[tid] = 0;
        __syncthreads();
        const int b = r0 / SEQ; const float* sh2 = mod + b * (NMOD * DM) + 3 * DM; const float* sc2 = mod + b * (NMOD * DM) + 4 * DM;
        for (int rr = 0; rr < 8; ++rr) {
            const int lrow = wave * 8 + rr, m = r0 + lrow;
            const float* xrow = (const float*)(p.ws + WS_X1) + (size_t)m * DM;
            f32x4 v[4]; float s = 0.f;
#pragma unroll
            for (int j = 0; j < 4; ++j) { v[j] = *(const f32x4*)(xrow + 4 * lane + 256 * j); s += (v[j].x * v[j].x + v[j].y * v[j].y) + (v[j].z * v[j].z + v[j].w * v[j].w); }
            const float rinv = 1.0f / sqrtf(wave_sum(s) * (1.f / DM) + EPS);
            bf16_t* orow = (bf16_t*)(p.ws + WS_H2) + (size_t)m * DM;
#pragma unroll
            for (int j = 0; j < 4; ++j) {
                const f32x4 gg = *(const f32x4*)(p.g_ffn + 4 * lane + 256 * j), cc = *(const f32x4*)(sc2 + 4 * lane + 256 * j), hh = *(const f32x4*)(sh2 + 4 * lane + 256 * j);
                v[j] = v[j] * rinv * gg * (1.0f + cc) + hh;
                u32x2 w; w.x = pk2(v[j].x, v[j].y); w.y = pk2(v[j].z, v[j].w);
                *(u32x2*)(orow + 4 * lane + 256 * j) = w;
            }
            float arr[32];
#pragma unroll
            for (int e = 0; e < 32; ++e) { float a = 0.f;
#pragma unroll
                for (int j = 0; j < 4; ++j) { const f32x4 w = *(const f32x4*)(wrT + e * DM + 4 * lane + 256 * j); a += (v[j].x * w.x + v[j].y * w.y) + (v[j].z * w.z + v[j].w * w.w); }
                arr[e] = a; }
#pragma unroll
            for (int e = 0; e < 16; ++e) { const bool up = lane & 32; const float send = up ? arr[e] : arr[e + 16]; const float keep = up ? arr[e + 16] : arr[e]; arr[e] = keep + __shfl_xor(send, 32); }
#pragma unroll
            for (int e = 0; e < 8; ++e) { const bool up = lane & 16; const float send = up ? arr[e] : arr[e + 8]; const float keep = up ? arr[e + 8] : arr[e]; arr[e] = keep + __shfl_xor(send, 16); }
#pragma unroll
            for (int e = 0; e < 4; ++e) { const bool up = lane & 8; const float send = up ? arr[e] : arr[e + 4]; const float keep = up ? arr[e + 4] : arr[e]; arr[e] = keep + __shfl_xor(send, 8); }
#pragma unroll
            for (int e = 0; e < 2; ++e) { const bool up = lane & 4; const float send = up ? arr[e] : arr[e + 2]; const float keep = up ? arr[e + 2] : arr[e]; arr[e] = keep + __shfl_xor(send, 4); }
            { const bool up = lane & 2; const float send = up ? arr[0] : arr[1]; const float keep = up ? arr[1] : arr[0]; arr[0] = keep + __shfl_xor(send, 2); }
            float lg = arr[0] + __shfl_xor(arr[0], 1);
            lg += p.b_router[(lane >> 1) & 31];
            float tv[4] = {-INFINITY, -INFINITY, -INFINITY, -INFINITY}; int ti[4] = {0, 0, 0, 0};
#pragma unroll
            for (int e = 0; e < 32; ++e) { const float val = __shfl(lg, 2 * e);
                if (val > tv[3]) { tv[3] = val; ti[3] = e;
                    if (tv[3] > tv[2]) { float t = tv[2]; tv[2] = tv[3]; tv[3] = t; int q = ti[2]; ti[2] = ti[3]; ti[3] = q;
                        if (tv[2] > tv[1]) { t = tv[1]; tv[1] = tv[2]; tv[2] = t; q = ti[1]; ti[1] = ti[2]; ti[2] = q;
                            if (tv[1] > tv[0]) { t = tv[0]; tv[0] = tv[1]; tv[1] = t; q = ti[0]; ti[0] = ti[1]; ti[1] = q; } } } } }
            const float e1 = __expf(tv[1] - tv[0]), e2 = __expf(tv[2] - tv[0]), e3 = __expf(tv[3] - tv[0]); const float inv = 1.0f / (1.0f + e1 + e2 + e3);
            if (lane < 4) { const int e = lane == 0 ? ti[0] : lane == 1 ? ti[1] : lane == 2 ? ti[2] : ti[3];
                const float gt = (lane == 0 ? 1.0f : lane == 1 ? e1 : lane == 2 ? e2 : e3) * inv;
                const int lp = atomicAdd(&hist[e], 1);
                rec[lrow * 4 + lane] = (e << 16) | lp;
                ((float*)(p.ws + WS_GATE))[(size_t)m * 4 + lane] = gt; }
        }
        __syncthreads();
        if (tid < 32) gbase[tid] = (int)atomicAdd(&cnt[tid], (unsigned)hist[tid]);
        __syncthreads();
        if (tid < 256) { const int lrow = tid >> 2, k = tid & 3, m = r0 + lrow; const int rc = rec[lrow * 4 + k], e = rc >> 16, pos = gbase[e] + (rc & 0xffff);
            ((int*)(p.ws + WS_LIST))[e * NTOK + pos] = m; ((int*)(p.ws + WS_TOKPOS))[(size_t)m * 4 + k] = e * NTOK + pos; }
        __syncthreads();
    }
}

__device__ __forceinline__ void phase_final(const Params& p, int bid, int nb) {
    const int lane = threadIdx.x & 63, wave = threadIdx.x >> 6, gw = bid * 8 + wave, NGW = nb * 8;
    const unsigned* cnt = (const unsigned*)(p.ws + WS_CTL) + CW_CNT;
    int mybase = 0; { int acc = 0; for (int e = 0; e < 32; ++e) { if (e == (lane & 31)) mybase = acc; acc += (int)((cnt[e] + 255u) >> 8) * 256; } }
    const float* mod = (const float*)(p.ws + WS_MOD);
    for (int m = gw; m < NTOK; m += NGW) {
        const int b = m / SEQ; const float* gt2 = mod + b * (NMOD * DM) + 5 * DM;
        const float* xrow = (const float*)(p.ws + WS_X1) + (size_t)m * DM;
        f32x4 acc[4];
#pragma unroll
        for (int j = 0; j < 4; ++j) acc[j] = (f32x4){0.f, 0.f, 0.f, 0.f};
#pragma unroll
        for (int k = 0; k < 4; ++k) {
            const int tp = ((const int*)(p.ws + WS_TOKPOS))[(size_t)m * 4 + k]; const float gk = ((const float*)(p.ws + WS_GATE))[(size_t)m * 4 + k];
            const int e = tp / NTOK, pos = tp % NTOK; const int row = __shfl(mybase, e) + pos;
            const bf16_t* yr = (const bf16_t*)(p.ws + WS_Y) + (size_t)row * DM;
#pragma unroll
            for (int j = 0; j < 4; ++j) { const u32x2 w = *(const u32x2*)(yr + 4 * lane + 256 * j);
                acc[j].x += gk * bflo(w.x); acc[j].y += gk * bfhi(w.x); acc[j].z += gk * bflo(w.y); acc[j].w += gk * bfhi(w.y); }
        }
        float s = 0.f;
#pragma unroll
        for (int j = 0; j < 4; ++j) { const f32x4 xv = *(const f32x4*)(xrow + 4 * lane + 256 * j), gg = *(const f32x4*)(gt2 + 4 * lane + 256 * j);
            acc[j] = xv + gg * acc[j]; s += (acc[j].x * acc[j].x + acc[j].y * acc[j].y) + (acc[j].z * acc[j].z + acc[j].w * acc[j].w); }
        const float rinv = 1.0f / sqrtf(wave_sum(s) * (1.f / DM) + EPS);
#pragma unroll
        for (int j = 0; j < 4; ++j) { const f32x4 gf = *(const f32x4*)(p.g_final + 4 * lane + 256 * j);
            *(f32x4*)(p.out + (size_t)m * DM + 4 * lane + 256 * j) = acc[j] * rinv * gf; }
    }
}

template <class Epi>
__global__ __launch_bounds__(256) void ngemm(const bf16_t* __restrict__ A, const bf16_t* __restrict__ Bt, int K, const int* __restrict__ rowmap,
                                             const int* __restrict__ tiles, size_t bstride, Epi epi) {
    __shared__ __attribute__((aligned(16))) bf16_t sA[64][40];
    __shared__ __attribute__((aligned(16))) bf16_t sB[64][40];
    const int bm = blockIdx.y * 64, bn = blockIdx.x * 64, tid = threadIdx.x, lane = tid & 63, w = tid >> 6, wr = w >> 1, wc = w & 1, fr = lane & 15, quad = lane >> 4;
    int expert = 0;
    if (tiles) { if (bm / 256 >= tiles[0]) return; expert = tiles[16 + bm / 256]; }
    const bf16_t* Bb = Bt + (size_t)expert * bstride;
    const int lr = tid >> 2, lc = (tid & 3) * 8;
    const int arow = rowmap ? rowmap[bm + lr] : bm + lr;
    const bf16_t* ap = A + (size_t)arow * K + lc; const bf16_t* bp = Bb + (size_t)(bn + lr) * K + lc;
    f32x4 acc[2][2];
#pragma unroll
    for (int i = 0; i < 2; ++i)
#pragma unroll
        for (int j = 0; j < 2; ++j) acc[i][j] = (f32x4){0.f, 0.f, 0.f, 0.f};
    for (int k0 = 0; k0 < K; k0 += 32) {
        *(u32x4*)&sA[lr][lc] = *(const u32x4*)(ap + k0); *(u32x4*)&sB[lr][lc] = *(const u32x4*)(bp + k0);
        __syncthreads();
        bf16x8 a[2], b[2];
#pragma unroll
        for (int i = 0; i < 2; ++i) { a[i] = *(const bf16x8*)&sA[wr * 32 + i * 16 + fr][quad * 8]; b[i] = *(const bf16x8*)&sB[wc * 32 + i * 16 + fr][quad * 8]; }
#pragma unroll
        for (int i = 0; i < 2; ++i)
#pragma unroll
            for (int j = 0; j < 2; ++j) acc[i][j] = __builtin_amdgcn_mfma_f32_16x16x32_bf16(a[i], b[j], acc[i][j], 0, 0, 0);
        __syncthreads();
    }
#pragma unroll
    for (int i = 0; i < 2; ++i)
#pragma unroll
        for (int j = 0; j < 2; ++j)
#pragma unroll
            for (int r = 0; r < 4; ++r) epi(bm + wr * 32 + i * 16 + quad * 4 + r, bn + wc * 32 + j * 16 + fr, acc[i][j][r], expert);
}
struct EpiProjN {
    const float* bias; const float* ropec; const float* ropes; bf16_t* out;
    __device__ __forceinline__ void operator()(int row, int col, float v, int) const {
        v += bias[col];
        const float other = __shfl_xor(v, 1);
        if (col < PC_ROPE_END) { const int f = (col & 63) >> 1; const float c = ropec[row * 32 + f], s = ropes[row * 32 + f];
            v = (col & 1) ? (v * c + other * s) : (v * c - other * s);
            if (col < PC_KA || (col >= PC_QD && col < PC_KD)) v *= C2; }
        out[(size_t)row * NPROJ + col] = (bf16_t)f2bf(v);
    }
};
struct EpiX1N {
    const float* x; const float* mod; const float* bias; float* out;
    __device__ __forceinline__ void operator()(int row, int col, float v, int) const {
        const int b = row / SEQ; out[(size_t)row * DM + col] = x[(size_t)row * DM + col] + mod[b * (NMOD * DM) + 2 * DM + col] * (v + bias[col]);
    }
};
struct EpiSwigluN {
    const float* b1; bf16_t* act;
    __device__ __forceinline__ void operator()(int row, int col, float v, int e) const {
        v += b1[(size_t)e * 2 * DFF + col];
        const float other = __shfl_xor(v, 1);
        if (!(col & 1)) { const float g = fminf(v, 7.0f), l = fminf(fmaxf(other, -7.0f), 7.0f);
            act[(size_t)row * DFF + (col >> 1)] = (bf16_t)f2bf(g / (1.0f + __expf(-1.702f * g)) * (l + 1.0f)); }
    }
};
struct EpiYN {
    const float* b2; bf16_t* y;
    __device__ __forceinline__ void operator()(int row, int col, float v, int e) const { y[(size_t)row * DM + col] = (bf16_t)f2bf(v + b2[(size_t)e * DM + col]); }
};

template <int MODE>
__global__ __launch_bounds__(64) void nattn(const bf16_t* __restrict__ proj, bf16_t* __restrict__ out, const float* __restrict__ sinks) {
    const int lane = threadIdx.x, row = blockIdx.x * 64 + lane, t = row % SEQ, rowb = row - t, t0 = (blockIdx.x * 64) % SEQ, hd = blockIdx.y;
    int qcol, kcol, vcol, ocol, opitch;
    if (MODE == 0) { const int hm = hd >> 1, half = hd & 1; qcol = PC_QD + hm * 64; kcol = PC_KD + hm * 64; vcol = PC_VD + (hm >> 1) * 128 + half * 64; ocol = hd * 64; opitch = DM; }
    else { qcol = PC_QA + hd * 64; kcol = PC_KA + (hd >> 2) * 64; vcol = PC_VA + (hd >> 2) * 64; ocol = hd * 64; opitch = DM; }
    float q[64], o[64];
#pragma unroll
    for (int i = 0; i < 8; ++i) { const u32x4 w = *(const u32x4*)(proj + (size_t)row * NPROJ + qcol + i * 8);
#pragma unroll
        for (int j = 0; j < 4; ++j) { q[i * 8 + 2 * j] = bflo(w[j]); q[i * 8 + 2 * j + 1] = bfhi(w[j]); } }
#pragma unroll
    for (int i = 0; i < 64; ++i) o[i] = 0.f;
    float m, l;
    if (MODE == 1) { m = sinks[hd] * LOG2E; l = 1.0f; } else { m = -INFINITY; l = 0.f; }
    const int jlo = MODE == 1 ? (t0 - 127 < 0 ? 0 : t0 - 127) : 0, jhi = t0 + 63;
    for (int j = jlo; j <= jhi; ++j) {
        const bf16_t* kr = proj + (size_t)(rowb + j) * NPROJ + kcol; const bf16_t* vr = proj + (size_t)(rowb + j) * NPROJ + vcol;
        float s = 0.f;
#pragma unroll
        for (int i = 0; i < 8; ++i) { const u32x4 w = *(const u32x4*)(kr + i * 8);
#pragma unroll
            for (int jj = 0; jj < 4; ++jj) { s += q[i * 8 + 2 * jj] * bflo(w[jj]); s += q[i * 8 + 2 * jj + 1] * bfhi(w[jj]); } }
        const bool vis = (j <= t) && (MODE == 0 || (t - j) < 128);
        if (!vis) s = -INFINITY;
        const float mn = fmaxf(m, s);
        if (mn == -INFINITY) continue;
        const float alpha = exp2f(m - mn), pj = exp2f(s - mn);
        l = l * alpha + pj; m = mn;
#pragma unroll
        for (int i = 0; i < 8; ++i) { const u32x4 w = *(const u32x4*)(vr + i * 8);
#pragma unroll
            for (int jj = 0; jj < 4; ++jj) { o[i * 8 + 2 * jj] = o[i * 8 + 2 * jj] * alpha + pj * bflo(w[jj]); o[i * 8 + 2 * jj + 1] = o[i * 8 + 2 * jj + 1] * alpha + pj * bfhi(w[jj]); } }
    }
    const float rl = 1.0f / l;
#pragma unroll
    for (int i = 0; i < 8; ++i) { u32x4 w;
#pragma unroll
        for (int jj = 0; jj < 4; ++jj) w[jj] = pk2(o[i * 8 + 2 * jj] * rl, o[i * 8 + 2 * jj + 1] * rl);
        *(u32x4*)(out + (size_t)row * opitch + ocol + i * 8) = w; }
}

__global__ void k_tiles(Params p) {
    const unsigned* cnt = (const unsigned*)(p.ws + WS_CTL) + CW_CNT; int* tl = (int*)(p.ws + WS_TILES); int* rowmap = (int*)(p.ws + WS_ROWMAP); const int* list = (const int*)(p.ws + WS_LIST);
    __shared__ int tb[33];
    if (threadIdx.x == 0) { int a = 0; for (int e = 0; e < 32; ++e) { tb[e] = a; a += (int)((cnt[e] + 255u) >> 8); } tb[32] = a; tl[0] = a; }
    __syncthreads();
    for (int t = blockIdx.x; t < tb[32]; t += gridDim.x) {
        int e = 0; while (t >= tb[e + 1]) ++e;
        const int mt = t - tb[e];
        if (threadIdx.x == 0) { tl[16 + t] = e; tl[512 + t] = mt; }
        for (int r = threadIdx.x; r < 256; r += blockDim.x) { const int pos = mt * 256 + r; rowmap[t * 256 + r] = pos < (int)cnt[e] ? list[e * NTOK + pos] : 0; }
    }
}

__global__ __launch_bounds__(512) void k_prep(Params p) { extern __shared__ __attribute__((aligned(16))) unsigned char lds[]; phase_prep(p, blockIdx.x, gridDim.x, (float*)lds); }
__global__ __launch_bounds__(512) void k_h1(Params p) { phase_h1(p, blockIdx.x, gridDim.x); }
__global__ __launch_bounds__(512) void k_combine(Params p) { phase_combine(p, blockIdx.x, gridDim.x); }
__global__ __launch_bounds__(512) void k_router(Params p) { extern __shared__ __attribute__((aligned(16))) unsigned char lds[]; phase_router(p, blockIdx.x, gridDim.x, lds); }
__global__ __launch_bounds__(512) void k_final(Params p) { phase_final(p, blockIdx.x, gridDim.x); }

extern "C" void kernel_launch(void* const* d_in, const int* in_sizes, int n_in, void* d_out, int out_size, void* d_ws, size_t ws_size, hipStream_t stream) {
    static int ok = 0;
    if (ok == 0) {
        if (n_in != 24 || in_sizes[0] != NTOK * DM || out_size != NTOK * DM || ws_size < WS_END) { fprintf(stderr, "kernel_launch: unexpected shapes (n_in %d in0 %d out %d ws %zu)\n", n_in, n_in > 0 ? in_sizes[0] : -1, out_size, ws_size); ok = -1; return; }
        if (hipFuncSetAttribute((const void*)k_router, hipFuncAttributeMaxDynamicSharedMemorySize, ROUTER_LDS) != hipSuccess) { fprintf(stderr, "kernel_launch: hipFuncSetAttribute failed\n"); ok = -1; return; }
        ok = 1;
    }
    if (ok < 0) return;
    Params p{};
    p.x = (const float*)d_in[0]; p.c = (const float*)d_in[1]; p.pos = (const int*)d_in[2]; p.w_ada = (const float*)d_in[3]; p.b_ada = (const float*)d_in[4]; p.g_mix = (const float*)d_in[5];
    p.w_in = (const float*)d_in[6]; p.b_in = (const float*)d_in[7]; p.sinks = (const float*)d_in[8]; p.lq1 = (const float*)d_in[9]; p.lk1 = (const float*)d_in[10]; p.lq2 = (const float*)d_in[11];
    p.lk2 = (const float*)d_in[12]; p.g_subln = (const float*)d_in[13]; p.w_out = (const float*)d_in[14]; p.b_out = (const float*)d_in[15]; p.g_ffn = (const float*)d_in[16];
    p.w_router = (const float*)d_in[17]; p.b_router = (const float*)d_in[18]; p.w1 = (const float*)d_in[19]; p.b1 = (const float*)d_in[20]; p.w2 = (const float*)d_in[21]; p.b2 = (const float*)d_in[22];
    p.g_final = (const float*)d_in[23]; p.out = (float*)d_out; p.ws = (unsigned char*)d_ws;
    unsigned char* ws = p.ws;
    (void)hipMemsetAsync(ws + WS_CTL, 0, CTL_ZERO_BYTES, stream);
    hipLaunchKernelGGL(k_prep, dim3(256), dim3(512), 4096, stream, p);
    hipLaunchKernelGGL(k_h1, dim3(256), dim3(512), 0, stream, p);
    { EpiProjN e{(const float*)(ws + WS_BINP), (const float*)(ws + WS_ROPE), (const float*)(ws + WS_ROPE) + (size_t)NTOK * 32, (bf16_t*)(ws + WS_PROJ)};
        hipLaunchKernelGGL(ngemm<EpiProjN>, dim3(NPROJ / 64, NTOK / 64), dim3(256), 0, stream, (const bf16_t*)(ws + WS_H1), (const bf16_t*)(ws + WS_WIN), DM, (const int*)nullptr, (const int*)nullptr, (size_t)0, e); }
    hipLaunchKernelGGL(nattn<1>, dim3(NTOK / 64, 8), dim3(64), 0, stream, (const bf16_t*)(ws + WS_PROJ), (bf16_t*)(ws + WS_MIXED), p.sinks);
    hipLaunchKernelGGL(nattn<0>, dim3(NTOK / 64, 16), dim3(64), 0, stream, (const bf16_t*)(ws + WS_PROJ), (bf16_t*)(ws + WS_OV), p.sinks);
    hipLaunchKernelGGL(k_combine, dim3(256), dim3(512), 0, stream, p);
    { EpiX1N e{p.x, (const float*)(ws + WS_MOD), p.b_out, (float*)(ws + WS_X1)};
        hipLaunchKernelGGL(ngemm<EpiX1N>, dim3(DM / 64, NTOK / 64), dim3(256), 0, stream, (const bf16_t*)(ws + WS_MIXED), (const bf16_t*)(ws + WS_WOUT), DM, (const int*)nullptr, (const int*)nullptr, (size_t)0, e); }
    hipLaunchKernelGGL(k_router, dim3(256), dim3(512), ROUTER_LDS, stream, p);
    hipLaunchKernelGGL(k_tiles, dim3(MAXTILES), dim3(256), 0, stream, p);
    { EpiSwigluN e{p.b1, (bf16_t*)(ws + WS_ACT)};
        hipLaunchKernelGGL(ngemm<EpiSwigluN>, dim3(2 * DFF / 64, MAXROWS / 64), dim3(256), 0, stream, (const bf16_t*)(ws + WS_H2), (const bf16_t*)(ws + WS_W1), DM, (const int*)(ws + WS_ROWMAP), (const int*)(ws + WS_TILES), (size_t)2 * DFF * DM, e); }
    { EpiYN e{p.b2, (bf16_t*)(ws + WS_Y)};
        hipLaunchKernelGGL(ngemm<EpiYN>, dim3(DM / 64, MAXROWS / 64), dim3(256), 0, stream, (const bf16_t*)(ws + WS_ACT), (const bf16_t*)(ws + WS_W2), DFF, (const int*)nullptr, (const int*)(ws + WS_TILES), (size_t)DM * DFF, e); }
    hipLaunchKernelGGL(k_final, dim3(256), dim3(512), 0, stream, p);
}
```

```cpp
#include <hip/hip_runtime.h>
#include <cstdint>
#include <cstdio>

constexpr int BATCH = 2, SEQ = 8192, NTOK = BATCH * SEQ, DM = 1024, NPROJ = 2304, NEXP = 32, TOPK = 4, DFF = 1024, NMOD = 6;
constexpr float EPS = 1e-5f;
constexpr float C2 = 0.125f * 1.4426950408889634f;
constexpr float LOG2E = 1.4426950408889634f;
constexpr float LAMBDA_INIT = 0.2f;
constexpr int PC_QA = 0, PC_KA = 512, PC_QD = 640, PC_KD = 1152, PC_VA = 1664, PC_VD = 1792, PC_ROPE_END = 1664;
constexpr int MAXTILES = 288;
constexpr int MAXROWS = MAXTILES * 256;

constexpr size_t MiB = 1u << 20;
constexpr size_t WS_CTL = 0, CTL_ZERO_BYTES = 256 * 1024;
constexpr size_t WS_MOD = 1 * MiB;
constexpr size_t WS_BINP = WS_MOD + 64 * 1024;
constexpr size_t WS_LAM = WS_BINP + 16 * 1024;
constexpr size_t WS_TILES = WS_LAM + 1024;
constexpr size_t WS_ROPE = 2 * MiB;
constexpr size_t WS_WIN = 8 * MiB;
constexpr size_t WS_WOUT = 14 * MiB;
constexpr size_t WS_W1 = 16 * MiB;
constexpr size_t WS_W2 = 144 * MiB;
constexpr size_t WS_H1 = 208 * MiB;
constexpr size_t WS_PROJ = 240 * MiB;
constexpr size_t WS_OV = 312 * MiB;
constexpr size_t WS_MIXED = 344 * MiB;
constexpr size_t WS_X1 = 376 * MiB;
constexpr size_t WS_H2 = 440 * MiB;
constexpr size_t WS_GATE = 474 * MiB;
constexpr size_t WS_TOKPOS = WS_GATE + 256 * 1024;
constexpr size_t WS_LIST = 475 * MiB;
constexpr size_t WS_ROWMAP = 478 * MiB;
constexpr size_t WS_ACT = 480 * MiB;
constexpr size_t WS_Y = 624 * MiB;
constexpr size_t WS_END = 768 * MiB;
constexpr int CW_CNT = 64;

__constant__ float ROPE_INV[32] = {
    1.000000000e+00f, 7.498942018e-01f, 5.623413324e-01f, 4.216965139e-01f, 3.162277639e-01f, 2.371373922e-01f, 1.778279394e-01f, 1.333521456e-01f,
    1.000000015e-01f, 7.498941571e-02f, 5.623412877e-02f, 4.216964915e-02f, 3.162277862e-02f, 2.371373586e-02f, 1.778279431e-02f, 1.333521493e-02f,
    9.999999776e-03f, 7.498942316e-03f, 5.623413250e-03f, 4.216964822e-03f, 3.162277862e-03f, 2.371373819e-03f, 1.778279431e-03f, 1.333521446e-03f,
    1.000000047e-03f, 7.498941850e-04f, 5.623413017e-04f, 4.216965463e-04f, 3.162277862e-04f, 2.371373848e-04f, 1.778279402e-04f, 1.333521504e-04f};
typedef unsigned short bf16_t;
typedef float f32x4 __attribute__((ext_vector_type(4)));
typedef short bf16x8 __attribute__((ext_vector_type(8)));
typedef unsigned u32x4 __attribute__((ext_vector_type(4)));
typedef unsigned u32x2 __attribute__((ext_vector_type(2)));

__device__ __forceinline__ unsigned f2bf(float f) { unsigned u = __float_as_uint(f); return (u + 0x7fffu + ((u >> 16) & 1u)) >> 16; }
__device__ __forceinline__ unsigned pk2(float lo, float hi) { return f2bf(lo) | (f2bf(hi) << 16); }
__device__ __forceinline__ float bf2f(unsigned h) { return __uint_as_float(h << 16); }
__device__ __forceinline__ float bflo(unsigned w) { return __uint_as_float(w << 16); }
__device__ __forceinline__ float bfhi(unsigned w) { return __uint_as_float(w & 0xffff0000u); }
__device__ __forceinline__ float wave_sum(float v) {
#pragma unroll
    for (int o = 1; o < 64; o <<= 1) v += __shfl_xor(v, o);
    return v;
}

struct Params {
    const float *x, *c; const int* pos; const float *w_ada, *b_ada, *g_mix, *w_in, *b_in, *sinks, *lq1, *lk1, *lq2, *lk2, *g_subln, *w_out, *b_out, *g_ffn,
        *w_router, *b_router, *w1, *b1, *w2, *b2, *g_final;
    float* out; unsigned char* ws;
};

__device__ __forceinline__ int proj_col_of_src(int s) {
    if (s < 640) { const int head = s >> 6, d = s & 63; return head * 64 + 2 * (d & 31) + (d >> 5); }
    if (s < 768) return PC_VA + (s - 640);
    if (s < 1792) { const int t = s - 768, head = t >> 6, d = t & 63; return PC_QD + head * 64 + 2 * (d & 31) + (d >> 5); }
    return s;
}

template <bool PERMUTE>
__device__ __forceinline__ void transpose_item(const float* __restrict__ W, int K, int N, bf16_t* __restrict__ WT, int item, int lane) {
    const int nblk = N / 32, kb = item / nblk, nb = item % nblk;
    const int k0 = 64 * kb + 8 * (lane >> 3), n0 = 32 * nb + 4 * (lane & 7);
    f32x4 v[8];
#pragma unroll
    for (int kk = 0; kk < 8; ++kk) v[kk] = *(const f32x4*)(W + (size_t)(k0 + kk) * N + n0);
#pragma unroll
    for (int i = 0; i < 4; ++i) {
        const int r = PERMUTE ? proj_col_of_src(n0 + i) : (n0 + i);
        u32x4 o; o.x = pk2(v[0][i], v[1][i]); o.y = pk2(v[2][i], v[3][i]); o.z = pk2(v[4][i], v[5][i]); o.w = pk2(v[6][i], v[7][i]);
        *(u32x4*)(WT + (size_t)r * K + k0) = o;
    }
}

__device__ __forceinline__ void sincos_acc(float angf, float& s, float& c) {
    const double a = (double)angf;
    const double n = __builtin_rint(a * 0.63661977236758134308);
    double r = __builtin_fma(-n, 1.57079632679489655800e+00, a);
    r = __builtin_fma(-n, 6.12323399573676603587e-17, r);
    const double r2 = r * r;
    double sp = -2.5052108385441718775e-08; sp = sp * r2 + 2.7557319223985890653e-06; sp = sp * r2 - 1.9841269841269841253e-04; sp = sp * r2 + 8.3333333333333332177e-03;
    sp = sp * r2 - 1.6666666666666665741e-01; const double sn = r + r * r2 * sp;
    double cp = 2.0876756987868098979e-09; cp = cp * r2 - 2.7557319223985888276e-07; cp = cp * r2 + 2.4801587301587301566e-05; cp = cp * r2 - 1.3888888888888889419e-03;
    cp = cp * r2 + 4.1666666666666664354e-02; const double cs = 1.0 - 0.5 * r2 + r2 * r2 * cp;
    const int q = ((int)n) & 3;
    const double ss = (q & 1) ? cs : sn, cc = (q & 1) ? sn : cs;
    s = (float)((q & 2) ? -ss : ss); c = (float)(((q + 1) & 2) ? -cc : cc);
}

__device__ __forceinline__ void phase_prep(const Params& p, int bid, int nb, float* lds) {
    const int tid = threadIdx.x, lane = tid & 63, wave = tid >> 6;
    unsigned char* ws = p.ws;
    for (int jc = bid; jc < NMOD * DM / 64; jc += nb) {
        const int j = jc * 64 + lane; float a0 = 0.f, a1 = 0.f;
        for (int k = wave * 128; k < wave * 128 + 128; ++k) {
            const float c0 = p.c[k], c1 = p.c[DM + k];
            const float s0 = c0 / (1.f + __expf(-c0)), s1 = c1 / (1.f + __expf(-c1));
            const float w = p.w_ada[(size_t)k * (NMOD * DM) + j];
            a0 += s0 * w; a1 += s1 * w;
        }
        lds[(wave * 2 + 0) * 64 + lane] = a0; lds[(wave * 2 + 1) * 64 + lane] = a1;
        __syncthreads();
        if (wave < 2) { float s = 0.f;
#pragma unroll
            for (int w = 0; w < 8; ++w) s += lds[(w * 2 + wave) * 64 + lane];
            ((float*)(ws + WS_MOD))[wave * (NMOD * DM) + j] = s + p.b_ada[j]; }
        __syncthreads();
    }
    { float* ct = (float*)(ws + WS_ROPE); float* st = ct + (size_t)NTOK * 32;
        for (int i = bid * 512 + tid; i < NTOK * 32; i += nb * 512) {
            const int row = i >> 5, f = i & 31;
            const float ang = (float)p.pos[row] * ROPE_INV[f];
            float s, c; sincos_acc(ang, s, c); ct[i] = c; st[i] = s; } }
    if (bid == nb - 1) {
        float* bp = (float*)(ws + WS_BINP);
        for (int s = tid; s < NPROJ; s += 512) bp[proj_col_of_src(s)] = p.b_in[s];
        if (wave == 0) { const float a = wave_sum(p.lq1[lane] * p.lk1[lane]), b = wave_sum(p.lq2[lane] * p.lk2[lane]);
            if (lane == 0) *(float*)(ws + WS_LAM) = expf(a) - expf(b) + LAMBDA_INIT; }
    }
    const int gw = bid * 8 + wave, NGW = nb * 8;
    constexpr int I_IN = (DM / 64) * (NPROJ / 32), I_OUT = (DM / 64) * (DM / 32), I_W1 = (DM / 64) * (2 * DFF / 32), I_W2 = (DFF / 64) * (DM / 32);
    constexpr int NITEMS = I_IN + I_OUT + NEXP * I_W1 + NEXP * I_W2;
    for (int it = gw; it < NITEMS; it += NGW) {
        int r = it;
        if (r < I_IN) { transpose_item<true>(p.w_in, DM, NPROJ, (bf16_t*)(ws + WS_WIN), r, lane); continue; } r -= I_IN;
        if (r < I_OUT) { transpose_item<false>(p.w_out, DM, DM, (bf16_t*)(ws + WS_WOUT), r, lane); continue; } r -= I_OUT;
        if (r < NEXP * I_W1) { const int e = r / I_W1; transpose_item<false>(p.w1 + (size_t)e * DM * 2 * DFF, DM, 2 * DFF, (bf16_t*)(ws + WS_W1) + (size_t)e * 2 * DFF * DM, r % I_W1, lane); continue; } r -= NEXP * I_W1;
        { const int e = r / I_W2; transpose_item<false>(p.w2 + (size_t)e * DFF * DM, DFF, DM, (bf16_t*)(ws + WS_W2) + (size_t)e * DM * DFF, r % I_W2, lane); }
    }
}

__device__ __forceinline__ void norm_mod_row(const float* xrow, const float* g, const float* sc, const float* sh, bf16_t* orow, int lane) {
    f32x4 v[4]; float s = 0.f;
#pragma unroll
    for (int j = 0; j < 4; ++j) { v[j] = *(const f32x4*)(xrow + 4 * lane + 256 * j); s += (v[j].x * v[j].x + v[j].y * v[j].y) + (v[j].z * v[j].z + v[j].w * v[j].w); }
    const float rinv = 1.0f / sqrtf(wave_sum(s) * (1.f / DM) + EPS);
#pragma unroll
    for (int j = 0; j < 4; ++j) {
        const f32x4 gg = *(const f32x4*)(g + 4 * lane + 256 * j), cc = *(const f32x4*)(sc + 4 * lane + 256 * j), hh = *(const f32x4*)(sh + 4 * lane + 256 * j);
        const f32x4 o = v[j] * rinv * gg * (1.0f + cc) + hh;
        u32x2 w; w.x = pk2(o.x, o.y); w.y = pk2(o.z, o.w);
        *(u32x2*)(orow + 4 * lane + 256 * j) = w;
    }
}
__device__ __forceinline__ void phase_h1(const Params& p, int bid, int nb) {
    const int lane = threadIdx.x & 63, wave = threadIdx.x >> 6, gw = bid * 8 + wave, NGW = nb * 8;
    const float* mod = (const float*)(p.ws + WS_MOD);
    for (int m = gw; m < NTOK; m += NGW) { const int b = m / SEQ;
        norm_mod_row(p.x + (size_t)m * DM, p.g_mix, mod + b * (NMOD * DM) + 1 * DM, mod + b * (NMOD * DM) + 0 * DM, (bf16_t*)(p.ws + WS_H1) + (size_t)m * DM, lane); }
}

__device__ __forceinline__ void phase_combine(const Params& p, int bid, int nb) {
    const int lane = threadIdx.x & 63, wave = threadIdx.x >> 6, gw = bid * 8 + wave, NGW = nb * 8;
    const float lam = *(const float*)(p.ws + WS_LAM);
    const int h = lane >> 4, e0 = (lane & 15) * 8, half = e0 >> 6, d0 = e0 & 63;
    float g[8];
#pragma unroll
    for (int i = 0; i < 8; ++i) g[i] = p.g_subln[e0 + i] * (1.0f - LAMBDA_INIT);
    for (int m = gw; m < NTOK; m += NGW) {
        const bf16_t* ov = (const bf16_t*)(p.ws + WS_OV) + (size_t)m * DM;
        const u32x4 a = *(const u32x4*)(ov + ((h * 2 + 0) * 2 + half) * 64 + d0), b = *(const u32x4*)(ov + ((h * 2 + 1) * 2 + half) * 64 + d0);
        float o[8]; float s = 0.f;
#pragma unroll
        for (int i = 0; i < 4; ++i) { o[2 * i] = bflo(a[i]) - lam * bflo(b[i]); o[2 * i + 1] = bfhi(a[i]) - lam * bfhi(b[i]); }
#pragma unroll
        for (int i = 0; i < 8; ++i) s += o[i] * o[i];
        s += __shfl_xor(s, 1); s += __shfl_xor(s, 2); s += __shfl_xor(s, 4); s += __shfl_xor(s, 8);
        const float rinv = 1.0f / sqrtf(s * (1.f / 128.f) + EPS);
        u32x4 w; w.x = pk2(o[0] * rinv * g[0], o[1] * rinv * g[1]); w.y = pk2(o[2] * rinv * g[2], o[3] * rinv * g[3]);
        w.z = pk2(o[4] * rinv * g[4], o[5] * rinv * g[5]); w.w = pk2(o[6] * rinv * g[6], o[7] * rinv * g[7]);
        *(u32x4*)((bf16_t*)(p.ws + WS_MIXED) + (size_t)m * DM + 512 + h * 128 + e0) = w;
    }
}

constexpr int ROUTER_LDS = 131072 + 4096;
__device__ __forceinline__ void phase_router(const Params& p, int bid, int nb, unsigned char* ldsb) {
    const int tid = threadIdx.x, lane = tid & 63, wave = tid >> 6;
    float* wrT = (float*)ldsb; int* hist = (int*)(ldsb + 131072); int* gbase = hist + 32; int* rec = hist + 64;
    unsigned* cnt = (unsigned*)(p.ws + WS_CTL) + CW_CNT;
    for (int i = tid; i < DM * NEXP; i += 512) { const int k = i >> 5, e = i & 31; wrT[e * DM + k] = p.w_router[i]; }
    __syncthreads();
    const float* mod = (const float*)(p.ws + WS_MOD);
    for (int r0 = bid * 64; r0 < NTOK; r0 += nb * 64) {
        if (tid < 32) hist[tid] = 0;
        __syncthreads();
        const int b = r0 / SEQ; const float* sh2 = mod + b * (NMOD * DM) + 3 * DM; const float* sc2 = mod + b * (NMOD * DM) + 4 * DM;
        for (int rr = 0; rr < 8; ++rr) {
            const int lrow = wave * 8 + rr, m = r0 + lrow;
            const float* xrow = (const float*)(p.ws + WS_X1) + (size_t)m * DM;
            f32x4 v[4]; float s = 0.f;
#pragma unroll
            for (int j = 0; j < 4; ++j) { v[j] = *(const f32x4*)(xrow + 4 * lane + 256 * j); s += (v[j].x * v[j].x + v[j].y * v[j].y) + (v[j].z * v[j].z + v[j].w * v[j].w); }
            const float rinv = 1.0f / sqrtf(wave_sum(s) * (1.f / DM) + EPS);
            bf16_t* orow = (bf16_t*)(p.ws + WS_H2) + (size_t)m * DM;
#pragma unroll
            for (int j = 0; j < 4; ++j) {
                const f32x4 gg = *(const f32x4*)(p.g_ffn + 4 * lane + 256 * j), cc = *(const f32x4*)(sc2 + 4 * lane + 256 * j), hh = *(const f32x4*)(sh2 + 4 * lane + 256 * j);
                v[j] = v[j] * rinv * gg * (1.0f + cc) + hh;
                u32x2 w; w.x = pk2(v[j].x, v[j].y); w.y = pk2(v[j].z, v[j].w);
                *(u32x2*)(orow + 4 * lane + 256 * j) = w;
            }
            float arr[32];
#pragma unroll
            for (int e = 0; e < 32; ++e) { float a = 0.f;
#pragma unroll
                for (int j = 0; j < 4; ++j) { const f32x4 w = *(const f32x4*)(wrT + e * DM + 4 * lane + 256 * j); a += (v[j].x * w.x + v[j].y * w.y) + (v[j].z * w.z + v[j].w * w.w); }
                arr[e] = a; }
#pragma unroll
            for (int e = 0; e < 16; ++e) { const bool up = lane & 32; const float send = up ? arr[e] : arr[e + 16]; const float keep = up ? arr[e + 16] : arr[e]; arr[e] = keep + __shfl_xor(send, 32); }
#pragma unroll
            for (int e = 0; e < 8; ++e) { const bool up = lane & 16; const float send = up ? arr[e] : arr[e + 8]; const float keep = up ? arr[e + 8] : arr[e]; arr[e] = keep + __shfl_xor(send, 16); }
#pragma unroll
            for (int e = 0; e < 4; ++e) { const bool up = lane & 8; const float send = up ? arr[e] : arr[e + 4]; const float keep = up ? arr[e + 4] : arr[e]; arr[e] = keep + __shfl_xor(send, 8); }
#pragma unroll
            for (int e = 0; e < 2; ++e) { const bool up = lane & 4; const float send = up ? arr[e] : arr[e + 2]; const float keep = up ? arr[e + 2] : arr[e]; arr[e] = keep + __shfl_xor(send, 4); }
            { const bool up = lane & 2; const float send = up ? arr[0] : arr[1]; const float keep = up ? arr[1] : arr[0]; arr[0] = keep + __shfl_xor(send, 2); }
            float lg = arr[0] + __shfl_xor(arr[0], 1);
            lg += p.b_router[(lane >> 1) & 31];
            float tv[4] = {-INFINITY, -INFINITY, -INFINITY, -INFINITY}; int ti[4] = {0, 0, 0, 0};
#pragma unroll
            for (int e = 0; e < 32; ++e) { const float val = __shfl(lg, 2 * e);
                if (val > tv[3]) { tv[3] = val; ti[3] = e;
                    if (tv[3] > tv[2]) { float t = tv[2]; tv[2] = tv[3]; tv[3] = t; int q = ti[2]; ti[2] = ti[3]; ti[3] = q;
                        if (tv[2] > tv[1]) { t = tv[1]; tv[1] = tv[2]; tv[2] = t; q = ti[1]; ti[1] = ti[2]; ti[2] = q;
                            if (tv[1] > tv[0]) { t = tv[0]; tv[0] = tv[1]; tv[1] = t; q = ti[0]; ti[0] = ti[1]; ti[1] = q; } } } } }
            const float e1 = __expf(tv[1] - tv[0]), e2 = __expf(tv[2] - tv[0]), e3 = __expf(tv[3] - tv[0]); const float inv = 1.0f / (1.0f + e1 + e2 + e3);
            if (lane < 4) { const int e = lane == 0 ? ti[0] : lane == 1 ? ti[1] : lane == 2 ? ti[2] : ti[3];
                const float gt = (lane == 0 ? 1.0f : lane == 1 ? e1 : lane == 2 ? e2 : e3) * inv;
                const int lp = atomicAdd(&hist[e], 1);
                rec[lrow * 4 + lane] = (e << 16) | lp;
                ((float*)(p.ws + WS_GATE))[(size_t)m * 4 + lane] = gt; }
        }
        __syncthreads();
        if (tid < 32) gbase[tid] = (int)atomicAdd(&cnt[tid], (unsigned)hist[tid]);
        __syncthreads();
        if (tid < 256) { const int lrow = tid >> 2, k = tid & 3, m = r0 + lrow; const int rc = rec[lrow * 4 + k], e = rc >> 16, pos = gbase[e] + (rc & 0xffff);
            ((int*)(p.ws + WS_LIST))[e * NTOK + pos] = m; ((int*)(p.ws + WS_TOKPOS))[(size_t)m * 4 + k] = e * NTOK + pos; }
        __syncthreads();
    }
}

__device__ __forceinline__ void phase_final(const Params& p, int bid, int nb) {
    const int lane = threadIdx.x & 63, wave = threadIdx.x >> 6, gw = bid * 8 + wave, NGW = nb * 8;
    const unsigned* cnt = (const unsigned*)(p.ws + WS_CTL) + CW_CNT;
    int mybase = 0; { int acc = 0; for (int e = 0; e < 32; ++e) { if (e == (lane & 31)) mybase = acc; acc += (int)((cnt[e] + 255u) >> 8) * 256; } }
    const float* mod = (const float*)(p.ws + WS_MOD);
    for (int m = gw; m < NTOK; m += NGW) {
        const int b = m / SEQ; const float* gt2 = mod + b * (NMOD * DM) + 5 * DM;
        const float* xrow = (const float*)(p.ws + WS_X1) + (size_t)m * DM;
        f32x4 acc[4];
#pragma unroll
        for (int j = 0; j < 4; ++j) acc[j] = (f32x4){0.f, 0.f, 0.f, 0.f};
#pragma unroll
        for (int k = 0; k < 4; ++k) {
            const int tp = ((const int*)(p.ws + WS_TOKPOS))[(size_t)m * 4 + k]; const float gk = ((const float*)(p.ws + WS_GATE))[(size_t)m * 4 + k];
            const int e = tp / NTOK, pos = tp % NTOK; const int row = __shfl(mybase, e) + pos;
            const bf16_t* yr = (const bf16_t*)(p.ws + WS_Y) + (size_t)row * DM;
#pragma unroll
            for (int j = 0; j < 4; ++j) { const u32x2 w = *(const u32x2*)(yr + 4 * lane + 256 * j);
                acc[j].x += gk * bflo(w.x); acc[j].y += gk * bfhi(w.x); acc[j].z += gk * bflo(w.y); acc[j].w += gk * bfhi(w.y); }
        }
        float s = 0.f;
#pragma unroll
        for (int j = 0; j < 4; ++j) { const f32x4 xv = *(const f32x4*)(xrow + 4 * lane + 256 * j), gg = *(const f32x4*)(gt2 + 4 * lane + 256 * j);
            acc[j] = xv + gg * acc[j]; s += (acc[j].x * acc[j].x + acc[j].y * acc[j].y) + (acc[j].z * acc[j].z + acc[j].w * acc[j].w); }
        const float rinv = 1.0f / sqrtf(wave_sum(s) * (1.f / DM) + EPS);
#pragma unroll
        for (int j = 0; j < 4; ++j) { const f32x4 gf = *(const f32x4*)(p.g_final + 4 * lane + 256 * j);
            *(f32x4*)(p.out + (size_t)m * DM + 4 * lane + 256 * j) = acc[j] * rinv * gf; }
    }
}

namespace pg8 {
#define PG8_LAS __attribute__((address_space(3)))
constexpr int BM = 256, BK = 64, HALF = 128, HTB = HALF * BK * 2  , STAGE_BYTES = 8 * HTB, NXCD = 8, WGM = 8;

__host__ __device__ __forceinline__ int lds_byte(int r, int c) { const int st = (r >> 4) * 2 + (c >> 5), rr = r & 15, cc = c & 31, ob = rr * 64 + cc * 2; return st * 1024 + (ob ^ (((ob >> 9) & 1) << 5)); }
__host__ __device__ __forceinline__ void stage_rc(int b, int& R, int& C) { const int st = b / 1024, sb = b % 1024, swz = sb ^ (((sb >> 9) & 1) << 5); R = (st >> 1) * 16 + swz / 64; C = (st & 1) * 32 + (swz % 64) / 2; }
__host__ __device__ __forceinline__ int perm32(int rho) { const int n = rho >> 4, i = rho & 15; return 8 * (i >> 2) + 4 * n + (i & 3); }

struct Unit { int pm, pn, e, mt; };
struct Gemm { const bf16_t* A; const bf16_t* Bt; int K; size_t bstride; };

__host__ __device__ __forceinline__ int xcd_remap(int wgid, int nwg) { const int q = nwg / NXCD, r = nwg % NXCD, xcd = wgid % NXCD, off = wgid / NXCD; return (xcd < r ? xcd * (q + 1) : r * (q + 1) + (xcd - r) * q) + off; }

struct StaticOrder {
    int nM, nN, nwg, G, c;
    __device__ void init(int M, int N, int G_, int c_) { nM = M / BM; nN = N / BM; nwg = nM * nN; G = G_; c = c_; }
    __device__ bool next(int i, Unit& u) const {
        const long L = (long)i * G + c; if (L >= nwg) return false;
        const int wgid = xcd_remap((int)L, nwg);
        const int nig = WGM * nN, gid = wgid / nig, fm = gid * WGM, gsz = (nM - fm) < WGM ? (nM - fm) : WGM;
        u.pm = fm + ((wgid % nig) % gsz); u.pn = (wgid % nig) / gsz; u.e = 0; u.mt = 0; return true;
    }
    __device__ __forceinline__ int row(const Unit& u, int r) const { return u.pm * BM + r; }
};
struct GroupedOrder {
    const PG8_LAS int* tb; const PG8_LAS int* cnt; const int* list; int nN, nwg, G, c;
    __device__ void init(const PG8_LAS int* tb_, const PG8_LAS int* cnt_, const int* list_, int nN_, int G_, int c_) { tb = tb_; cnt = cnt_; list = list_; nN = nN_; nwg = tb_[32] * nN_; G = G_; c = c_; }
    __device__ bool next(int i, Unit& u) const {
        const long L = (long)i * G + c; if (L >= nwg) return false;
        const int wgid = xcd_remap((int)L, nwg);
        const int t = wgid / nN; int e = 0; while (t >= tb[e + 1]) ++e;
        u.pm = t; u.pn = wgid % nN; u.e = e; u.mt = t - tb[e]; return true;
    }
    __device__ __forceinline__ int row(const Unit& u, int r) const { const int pos = u.mt * BM + r; return pos < cnt[u.e] ? list[u.e * NTOK + pos] : 0; }
};

__device__ __forceinline__ unsigned cvt_pk_bf16(float lo, float hi) { unsigned r; asm volatile("v_cvt_pk_bf16_f32 %0, %1, %2" : "=v"(r) : "v"(lo), "v"(hi)); return r; }

struct EpiProj {
    static constexpr bool PERM = true;
    bf16_t* O; const float* bias; const float* ropec; const float* ropes;
    __device__ __forceinline__ void operator()(const f32x4 (&acc)[2][2][4][2], const Unit& u, int wr, int wc, int fr, int fq) const {
        const int row0 = u.pm * BM + wr * 64 + fr, colb = u.pn * BM + wc * 32 + 8 * fq, f0 = ((wc * 32 + 8 * fq) & 63) >> 1;
        f32x4 bv[2][2];
#pragma unroll
        for (int bj = 0; bj < 2; ++bj)
#pragma unroll
            for (int n = 0; n < 2; ++n) bv[bj][n] = *(const f32x4*)(bias + colb + bj * HALF + 4 * n);
#pragma unroll
        for (int ai = 0; ai < 2; ++ai)
#pragma unroll
            for (int m = 0; m < 4; ++m) { const int row = row0 + ai * HALF + m * 16;
                const f32x4 cs = *(const f32x4*)(ropec + (size_t)row * 32 + f0), sn = *(const f32x4*)(ropes + (size_t)row * 32 + f0);
                bf16_t* rowp = O + (size_t)row * NPROJ + colb;
#pragma unroll
                for (int bj = 0; bj < 2; ++bj) { const int hidx = u.pn * 2 + bj;
                    f32x4 v0 = acc[ai][bj][m][0] + bv[bj][0], v1 = acc[ai][bj][m][1] + bv[bj][1];
                    if (hidx < PC_ROPE_END / HALF) {
                        f32x4 w0, w1;
                        w0[0] = v0[0] * cs[0] - v0[1] * sn[0]; w0[1] = v0[1] * cs[0] + v0[0] * sn[0]; w0[2] = v0[2] * cs[1] - v0[3] * sn[1]; w0[3] = v0[3] * cs[1] + v0[2] * sn[1];
                        w1[0] = v1[0] * cs[2] - v1[1] * sn[2]; w1[1] = v1[1] * cs[2] + v1[0] * sn[2]; w1[2] = v1[2] * cs[3] - v1[3] * sn[3]; w1[3] = v1[3] * cs[3] + v1[2] * sn[3];
                        const float sc = (hidx < PC_KA / HALF || (hidx >= PC_QD / HALF && hidx < PC_KD / HALF)) ? C2 : 1.0f;
                        v0 = w0 * sc; v1 = w1 * sc; }
                    u32x4 w; w.x = cvt_pk_bf16(v0[0], v0[1]); w.y = cvt_pk_bf16(v0[2], v0[3]); w.z = cvt_pk_bf16(v1[0], v1[1]); w.w = cvt_pk_bf16(v1[2], v1[3]);
                    *(u32x4*)(rowp + bj * HALF) = w; } }
    }
};
struct EpiX1 {
    static constexpr bool PERM = false;
    const float* x; const float* mod; const float* bias; float* out;
    __device__ __forceinline__ void operator()(const f32x4 (&acc)[2][2][4][2], const Unit& u, int wr, int wc, int fr, int fq) const {
        const int row0 = u.pm * BM + wr * 64 + fr, col0 = u.pn * BM + wc * 32 + 4 * fq; const float* gt = mod + ((u.pm * BM) / SEQ) * (NMOD * DM) + 2 * DM;
#pragma unroll
        for (int bj = 0; bj < 2; ++bj)
#pragma unroll
            for (int n = 0; n < 2; ++n) { const int c = col0 + bj * HALF + n * 16; const f32x4 bv = *(const f32x4*)(bias + c), gv = *(const f32x4*)(gt + c);
#pragma unroll
                for (int ai = 0; ai < 2; ++ai)
#pragma unroll
                    for (int m = 0; m < 4; ++m) { const size_t off = (size_t)(row0 + ai * HALF + m * 16) * DM + c;
                        *(f32x4*)(out + off) = *(const f32x4*)(x + off) + gv * (acc[ai][bj][m][n] + bv); } }
    }
};
__device__ __forceinline__ float swiglu1(float g, float l) { g = fminf(g, 7.0f); l = fminf(fmaxf(l, -7.0f), 7.0f); return g * __builtin_amdgcn_rcpf(1.0f + __builtin_amdgcn_exp2f(-1.702f * LOG2E * g)) * (l + 1.0f); }
struct EpiSwiglu {
    static constexpr bool PERM = true;
    const float* b1; bf16_t* act;
    __device__ __forceinline__ void operator()(const f32x4 (&acc)[2][2][4][2], const Unit& u, int wr, int wc, int fr, int fq) const {
        const int row0 = u.pm * BM + wr * 64 + fr, colb = u.pn * BM + wc * 32 + 8 * fq; const float* bias = b1 + (size_t)u.e * (2 * DFF);
        f32x4 bv[2][2];
#pragma unroll
        for (int bj = 0; bj < 2; ++bj)
#pragma unroll
            for (int n = 0; n < 2; ++n) bv[bj][n] = *(const f32x4*)(bias + colb + bj * HALF + 4 * n);
#pragma unroll
        for (int ai = 0; ai < 2; ++ai)
#pragma unroll
            for (int m = 0; m < 4; ++m) { bf16_t* rowp = act + (size_t)(row0 + ai * HALF + m * 16) * DFF + (colb >> 1);
#pragma unroll
                for (int bj = 0; bj < 2; ++bj) { const f32x4 v0 = acc[ai][bj][m][0] + bv[bj][0], v1 = acc[ai][bj][m][1] + bv[bj][1];
                    u32x2 w; w.x = cvt_pk_bf16(swiglu1(v0[0], v0[1]), swiglu1(v0[2], v0[3])); w.y = cvt_pk_bf16(swiglu1(v1[0], v1[1]), swiglu1(v1[2], v1[3]));
                    *(u32x2*)(rowp + bj * (HALF / 2)) = w; } }
    }
};
struct EpiY {
    static constexpr bool PERM = true;
    const float* b2; bf16_t* y;
    __device__ __forceinline__ void operator()(const f32x4 (&acc)[2][2][4][2], const Unit& u, int wr, int wc, int fr, int fq) const {
        const int row0 = u.pm * BM + wr * 64 + fr, colb = u.pn * BM + wc * 32 + 8 * fq; const float* bias = b2 + (size_t)u.e * DM;
        f32x4 bv[2][2];
#pragma unroll
        for (int bj = 0; bj < 2; ++bj)
#pragma unroll
            for (int n = 0; n < 2; ++n) bv[bj][n] = *(const f32x4*)(bias + colb + bj * HALF + 4 * n);
#pragma unroll
        for (int ai = 0; ai < 2; ++ai)
#pragma unroll
            for (int m = 0; m < 4; ++m) { bf16_t* rowp = y + (size_t)(row0 + ai * HALF + m * 16) * DM + colb;
#pragma unroll
                for (int bj = 0; bj < 2; ++bj) { const f32x4 v0 = acc[ai][bj][m][0] + bv[bj][0], v1 = acc[ai][bj][m][1] + bv[bj][1];
                    u32x4 w; w.x = cvt_pk_bf16(v0[0], v0[1]); w.y = cvt_pk_bf16(v0[2], v0[3]); w.z = cvt_pk_bf16(v1[0], v1[1]); w.w = cvt_pk_bf16(v1[2], v1[3]);
                    *(u32x4*)(rowp + bj * HALF) = w; } }
    }
};

template <class Epi, class Sched, bool GATHER>
__device__ __forceinline__ void gemm_phase(PG8_LAS unsigned char* lds, const Gemm g, const Sched& S, const Epi& E) {
    const int tid = threadIdx.x, wid = __builtin_amdgcn_readfirstlane(tid >> 6), lane = tid & 63, wr = wid >> 2, wc = wid & 3, fr = lane & 15, fq = lane >> 4;
    const int K = g.K, nt = K / BK;
    unsigned voffA[2], voffB[2]; int RA[2], CA[2];
#pragma unroll
    for (int i = 0; i < 2; ++i) { int R, C; stage_rc(tid * 16 + i * 8192, R, C); const int Rb = Epi::PERM ? ((R & ~31) + perm32(R & 31)) : R;
        voffA[i] = (unsigned)(R * K + C) * 2u; voffB[i] = (unsigned)(Rb * K + C) * 2u; RA[i] = R; CA[i] = C; }
    const size_t kstep = (size_t)(BK * 2);
    const size_t hstep = (size_t)HALF * K * 2;
    const size_t tstep = 2 * hstep;
    const unsigned ldsw = (unsigned)wid * 1024u;
    const int aoff = lds_byte(wr * 64 + fr, fq * 8), boff = lds_byte(wc * 32 + fr, fq * 8);
    const char* gA = (const char*)g.A;
#define PG8_SA(b, h) (((b) * 2 + (h)) * HTB)
#define PG8_SB(b, h) ((4 + (b) * 2 + (h)) * HTB)
#define PG8_STAGE(bufoff, gbase, voff) do { _Pragma("unroll") for (int _i = 0; _i < 2; ++_i) \
        __builtin_amdgcn_global_load_lds((const unsigned*)((const char*)(gbase) + (voff)[_i]), (PG8_LAS unsigned*)(lds + (bufoff) + ldsw + _i * 8192), 16, 0, 0); } while (0)
#define PG8_STAGE_A(bufoff, dptr, kb, go) do { _Pragma("unroll") for (int _i = 0; _i < 2; ++_i) { \
        const char* _s = GATHER ? (gA + (kb) + (go)[_i]) : ((const char*)(dptr) + voffA[_i]); \
        __builtin_amdgcn_global_load_lds((const unsigned*)_s, (PG8_LAS unsigned*)(lds + (bufoff) + ldsw + _i * 8192), 16, 0, 0); } } while (0)
#define PG8_LDA(dst, b, h) do { _Pragma("unroll") for (int m = 0; m < 4; ++m) _Pragma("unroll") for (int k = 0; k < 2; ++k) dst[m][k] = *(const PG8_LAS bf16x8*)(lds + PG8_SA(b, h) + aoff + m * 2048 + k * 1024); } while (0)
#define PG8_LDB(dst, b, h) do { _Pragma("unroll") for (int n = 0; n < 2; ++n) _Pragma("unroll") for (int k = 0; k < 2; ++k) dst[n][k] = *(const PG8_LAS bf16x8*)(lds + PG8_SB(b, h) + boff + n * 2048 + k * 1024); } while (0)
#define PG8_MMA(ai, bj, At, Bt) do { __builtin_amdgcn_s_setprio(1); _Pragma("unroll") for (int m = 0; m < 4; ++m) _Pragma("unroll") for (int n = 0; n < 2; ++n) _Pragma("unroll") for (int k = 0; k < 2; ++k) \
        acc[ai][bj][m][n] = __builtin_amdgcn_mfma_f32_16x16x32_bf16(Bt[n][k], At[m][k], acc[ai][bj][m][n], 0, 0, 0); __builtin_amdgcn_s_setprio(0); } while (0)
#define PG8_WAIT_V(n) asm volatile("s_waitcnt vmcnt(" #n ")" ::: "memory")
#define PG8_WAIT_L(n) asm volatile("s_waitcnt lgkmcnt(" #n ")" ::: "memory")
#define PG8_BAR __builtin_amdgcn_s_barrier()
#define PG8_SCHED __builtin_amdgcn_sched_barrier(0)
#define PG8_GOFFS(dst, un) do { if (GATHER) { _Pragma("unroll") for (int _h = 0; _h < 2; ++_h) _Pragma("unroll") for (int _i = 0; _i < 2; ++_i) \
        dst[_h][_i] = (unsigned)S.row(un, _h * HALF + RA[_i]) * (unsigned)(K * 2) + (unsigned)(CA[_i] * 2); } } while (0)
    Unit cur, nxt; int ui = 0;
    if (!S.next(0, cur)) return;
    f32x4 acc[2][2][4][2];
#pragma unroll
    for (int a = 0; a < 2; ++a)
#pragma unroll
        for (int b = 0; b < 2; ++b)
#pragma unroll
            for (int m = 0; m < 4; ++m)
#pragma unroll
                for (int n = 0; n < 2; ++n) acc[a][b][m][n] = (f32x4){0.f, 0.f, 0.f, 0.f};
    bf16x8 At[4][2], B0[2][2], B1[2][2];
    unsigned gcur[2][2] = {{0u, 0u}, {0u, 0u}}, gnxt[2][2] = {{0u, 0u}, {0u, 0u}};
    PG8_GOFFS(gcur, cur);
    const char* cA = gA + (GATHER ? (size_t)0 : (size_t)cur.pm * tstep); const char* cB = (const char*)g.Bt + ((size_t)cur.e * g.bstride) * 2 + (size_t)cur.pn * tstep;
    PG8_STAGE(PG8_SB(0, 0), cB, voffB); PG8_STAGE(PG8_SB(0, 1), cB + hstep, voffB); PG8_STAGE_A(PG8_SA(0, 0), cA, (size_t)0, gcur[0]); PG8_STAGE_A(PG8_SA(0, 1), cA + hstep, (size_t)0, gcur[1]);
    if (wr == 1) PG8_BAR;
    PG8_WAIT_V(2); PG8_BAR;
    PG8_STAGE(PG8_SB(1, 0), cB + kstep, voffB); PG8_STAGE_A(PG8_SA(1, 0), cA + kstep, kstep, gcur[0]); PG8_STAGE(PG8_SB(1, 1), cB + hstep + kstep, voffB);
    PG8_WAIT_V(6); PG8_BAR;
    for (;;) {
        const bool has_next = S.next(ui + 1, nxt);
        if (has_next) PG8_GOFFS(gnxt, nxt);
        const char* nA = (has_next && !GATHER) ? gA + (size_t)nxt.pm * tstep : cA; const char* nB = has_next ? (const char*)g.Bt + ((size_t)nxt.e * g.bstride) * 2 + (size_t)nxt.pn * tstep : cB;
        for (int t = 0; t < nt; t += 2) {
            const bool last = (t == nt - 2);
            const char* a1 = cA + (size_t)(t + 1) * kstep;
            const char* a2 = last ? nA : cA + (size_t)(t + 2) * kstep; const char* b2 = last ? nB : cB + (size_t)(t + 2) * kstep;
            const char* a3 = a2 + kstep; const char* b3 = b2 + kstep;
            const size_t k1 = (size_t)(t + 1) * kstep, k2 = last ? (size_t)0 : (size_t)(t + 2) * kstep, k3 = k2 + kstep;
            unsigned gsel[2][2];
#pragma unroll
            for (int h = 0; h < 2; ++h)
#pragma unroll
                for (int i = 0; i < 2; ++i) gsel[h][i] = (last && has_next) ? gnxt[h][i] : gcur[h][i];
            PG8_LDB(B0, 0, 0); PG8_LDB(B1, 0, 1); PG8_SCHED; PG8_LDA(At, 0, 0); PG8_STAGE_A(PG8_SA(1, 1), a1 + hstep, k1, gcur[1]);
            PG8_WAIT_V(8); PG8_WAIT_L(0); PG8_BAR; PG8_MMA(0, 0, At, B0); PG8_MMA(0, 1, At, B1); PG8_BAR; PG8_SCHED;
            PG8_LDA(At, 0, 1); PG8_STAGE(PG8_SB(0, 0), b2, voffB); PG8_STAGE(PG8_SB(0, 1), b2 + hstep, voffB); PG8_STAGE_A(PG8_SA(0, 0), a2, k2, gsel[0]);
            PG8_WAIT_V(8); PG8_WAIT_L(0); PG8_BAR; PG8_MMA(1, 0, At, B0); PG8_MMA(1, 1, At, B1); PG8_BAR; PG8_SCHED;
            PG8_LDB(B0, 1, 0); PG8_LDB(B1, 1, 1); PG8_SCHED; PG8_LDA(At, 1, 0); PG8_STAGE_A(PG8_SA(0, 1), a2 + hstep, k2, gsel[1]);
            PG8_WAIT_V(8); PG8_WAIT_L(0); PG8_BAR; PG8_MMA(0, 0, At, B0); PG8_MMA(0, 1, At, B1); PG8_BAR; PG8_SCHED;
            PG8_LDA(At, 1, 1); PG8_STAGE(PG8_SB(1, 0), b3, voffB); PG8_STAGE(PG8_SB(1, 1), b3 + hstep, voffB); PG8_STAGE_A(PG8_SA(1, 0), a3, k3, gsel[0]);
            PG8_WAIT_V(8); PG8_WAIT_L(0); PG8_BAR; PG8_MMA(1, 0, At, B0); PG8_MMA(1, 1, At, B1); PG8_BAR; PG8_SCHED;
        }
        if (wr == 0) PG8_BAR;
        E(acc, cur, wr, wc, fr, fq);
        if (!has_next) break;
#pragma unroll
        for (int a = 0; a < 2; ++a)
#pragma unroll
            for (int b = 0; b < 2; ++b)
#pragma unroll
                for (int m = 0; m < 4; ++m)
#pragma unroll
                    for (int n = 0; n < 2; ++n) acc[a][b][m][n] = (f32x4){0.f, 0.f, 0.f, 0.f};
        cur = nxt; cA = nA; cB = nB; ++ui;
#pragma unroll
        for (int h = 0; h < 2; ++h)
#pragma unroll
            for (int i = 0; i < 2; ++i) gcur[h][i] = gnxt[h][i];
        if (wr == 1) PG8_BAR;
    }
    PG8_WAIT_V(0);
    PG8_BAR;
#undef PG8_SA
#undef PG8_SB
#undef PG8_STAGE
#undef PG8_STAGE_A
#undef PG8_LDA
#undef PG8_LDB
#undef PG8_MMA
#undef PG8_WAIT_V
#undef PG8_WAIT_L
#undef PG8_BAR
#undef PG8_SCHED
#undef PG8_GOFFS
}
}
namespace attn_body {
using bf16=unsigned short;
using bf16x8=__attribute__((ext_vector_type(8)))short;
using s16x4=__attribute__((ext_vector_type(4)))short;
using f32x16=__attribute__((ext_vector_type(16)))float;
using u32x4=__attribute__((ext_vector_type(4)))unsigned;
constexpr int D=64,DM=2304;
constexpr int NW=8,QBLK=32,QB=QBLK*NW,KVBLK=64;
__device__ __forceinline__ int crow(int r,int hi){return (r&3)+8*(r>>2)+4*hi;}
#define SBAR() __builtin_amdgcn_sched_barrier(0)
__device__ __forceinline__ void cmask(f32x16&p0,f32x16&p1,int jb,int qrel,int hi){
  const float NEG=-INFINITY; int kb=64*jb+4*hi;
  #pragma unroll
  for(int r=0;r<16;++r){int kv=kb+(r&3)+8*(r>>2); if(kv>qrel)p0[r]=NEG; if(kv+32>qrel)p1[r]=NEG;}
}

__device__ __forceinline__ void smask(f32x16&p0,f32x16&p1,int t,int qrel,int hi,int shift){
  const float NEG=-INFINITY; int kb=64*t-shift+4*hi;
  #pragma unroll
  for(int r=0;r<16;++r){int kv=kb+(r&3)+8*(r>>2); if(kv>qrel||kv<=qrel-128)p0[r]=NEG; if(kv+32>qrel||kv+32<=qrel-128)p1[r]=NEG;}
}
constexpr int NSLOT=3, SLOTB=8192;
constexpr int LDS_K=0, LDS_V=NSLOT*SLOTB, LDS_WS=2*NSLOT*SLOTB, LDS_OST=LDS_WS+NW*64*4, LDS_BYTES=LDS_OST+NW*4096;
__device__ __forceinline__ void glds16(const void*gsrc,unsigned lds_dst){unsigned keep;
  asm volatile("s_mov_b32 %0, m0\n\ts_mov_b32 m0, %2\n\ts_nop 0\n\tglobal_load_lds_dwordx4 %1, off\n\ts_mov_b32 m0, %0":"=&s"(keep):"v"(gsrc),"s"(lds_dst):"memory");}
__device__ __forceinline__ float max3f(float a,float b,float c){float r;asm("v_max3_f32 %0, %1, %2, %3":"=v"(r):"v"(a),"v"(b),"v"(c));return r;}
__device__ __forceinline__ float max2f(float a,float b){float r;asm("v_max_f32_e32 %0, %1, %2":"=v"(r):"v"(a),"v"(b));return r;}
__device__ __forceinline__ float fadd_s(float a,float b){float r;asm("v_add_f32_e32 %0, %1, %2":"=v"(r):"v"(a),"v"(b));return r;}
__device__ __forceinline__ float fsub_s(float a,float b){float r;asm("v_sub_f32_e32 %0, %1, %2":"=v"(r):"v"(a),"v"(b));return r;}
typedef float f32x2_t __attribute__((ext_vector_type(2))); typedef __bf16 bf16x2_t __attribute__((ext_vector_type(2)));
__device__ __forceinline__ unsigned cvtpk_s(float lo,float hi){f32x2_t v={lo,hi};bf16x2_t b=__builtin_convertvector(v,bf16x2_t);return __builtin_bit_cast(unsigned,b);}
#define WAIT_BAR(N) asm volatile("s_waitcnt vmcnt(" #N ") lgkmcnt(0)\n\ts_barrier":::"memory")

__device__ __forceinline__ void qkt(f32x16&p0,f32x16&p1,const char*Kslot,const bf16x8*qr,const f32x16&negm,int r32,int hi){
  const char*kb=Kslot+hi*1024+r32*16;
  #pragma unroll
  for(int d0=0;d0<4;++d0){
    const bf16x8 b0=*reinterpret_cast<const bf16x8*>(kb+d0*2048);
    const bf16x8 b1=*reinterpret_cast<const bf16x8*>(kb+d0*2048+512);
    if(d0==0){p0=__builtin_amdgcn_mfma_f32_32x32x16_bf16(b0,qr[0],negm,0,0,0);p1=__builtin_amdgcn_mfma_f32_32x32x16_bf16(b1,qr[0],negm,0,0,0);}
    else{p0=__builtin_amdgcn_mfma_f32_32x32x16_bf16(b0,qr[d0],p0,0,0,0);p1=__builtin_amdgcn_mfma_f32_32x32x16_bf16(b1,qr[d0],p1,0,0,0);}}
}
typedef __attribute__((address_space(3))) const char* lds_cptr;
typedef short v4i16_t __attribute__((ext_vector_type(4)));
__device__ __forceinline__ void kload8(bf16x8*kf,lds_cptr kp){
  kf[0]=*(const __attribute__((address_space(3))) bf16x8*)(kp);      kf[1]=*(const __attribute__((address_space(3))) bf16x8*)(kp+512);
  kf[2]=*(const __attribute__((address_space(3))) bf16x8*)(kp+2048); kf[3]=*(const __attribute__((address_space(3))) bf16x8*)(kp+2560);
  kf[4]=*(const __attribute__((address_space(3))) bf16x8*)(kp+4096); kf[5]=*(const __attribute__((address_space(3))) bf16x8*)(kp+4608);
  kf[6]=*(const __attribute__((address_space(3))) bf16x8*)(kp+6144); kf[7]=*(const __attribute__((address_space(3))) bf16x8*)(kp+6656);
}
__device__ __forceinline__ void kload2(bf16x8*kf,lds_cptr kp,int j){ kf[2*j]=*(const __attribute__((address_space(3))) bf16x8*)(kp+j*2048); kf[2*j+1]=*(const __attribute__((address_space(3))) bf16x8*)(kp+j*2048+512); }
__device__ __forceinline__ s16x4 vtr(lds_cptr p){ return __builtin_bit_cast(s16x4,__builtin_amdgcn_ds_read_tr16_b64_v4i16((__attribute__((address_space(3))) v4i16_t*)p)); }
__device__ __forceinline__ float rowmax(const f32x16&p0,const f32x16&p1){
  float a=max3f(p0[0],p0[1],p1[0]),b=max3f(p0[2],p0[3],p1[1]);a=max3f(a,p1[2],p1[3]);
  #pragma unroll
  for(int r=4;r<16;r+=4){a=max3f(a,p0[r],p0[r+1]);b=max3f(b,p0[r+2],p0[r+3]);a=max3f(a,p1[r],p1[r+1]);b=max3f(b,p1[r+2],p1[r+3]);}
  const float m=max2f(a,b);
  auto rr=__builtin_amdgcn_permlane32_swap(__float_as_uint(m),__float_as_uint(m),false,false);
  return max2f(__uint_as_float(rr[0]),__uint_as_float(rr[1]));
}
__device__ __forceinline__ void pv(f32x16*o,int vb,bf16x8 pa0,bf16x8 pa1,bf16x8 pa2,bf16x8 pa3){
  #pragma unroll
  for(int d0=0;d0<2;++d0){s16x4 lo[4],hi[4];
    #pragma unroll
    for(int ks=0;ks<4;++ks){
      asm volatile("ds_read_b64_tr_b16 %0,%1 offset:%c2":"=&v"(lo[ks]):"v"(vb),"i"(d0*4096+ks*1024):"memory");
      asm volatile("ds_read_b64_tr_b16 %0,%1 offset:%c2":"=&v"(hi[ks]):"v"(vb),"i"(d0*4096+ks*1024+512):"memory");}
    asm volatile("s_waitcnt lgkmcnt(0)":::"memory");SBAR();
    #define PK(k) (bf16x8){lo[k][0],lo[k][1],lo[k][2],lo[k][3],hi[k][0],hi[k][1],hi[k][2],hi[k][3]}
    o[d0]=__builtin_amdgcn_mfma_f32_32x32x16_bf16(pa0,PK(0),o[d0],0,0,0);
    o[d0]=__builtin_amdgcn_mfma_f32_32x32x16_bf16(pa1,PK(1),o[d0],0,0,0);
    o[d0]=__builtin_amdgcn_mfma_f32_32x32x16_bf16(pa2,PK(2),o[d0],0,0,0);
    o[d0]=__builtin_amdgcn_mfma_f32_32x32x16_bf16(pa3,PK(3),o[d0],0,0,0);
    #undef PK
  }
}

#ifndef ATTN_STORE16
#define ATTN_STORE16(p,v) (*(u32x4*)(p)=(v))
#endif
template<int THRL,int MODE> __device__ __forceinline__ void attn_unit(const bf16*Qu,const bf16*__restrict__ Kh,const bf16*__restrict__ Vh,bf16*Ou,const int opitch,const int NT,const int shift,const float sink2,char*shm){
  int tid_=threadIdx.x; asm volatile("":"+v"(tid_));
  const int tid=tid_,lane=tid&63,r32=lane&31,hi=lane>>5; const int wid=__builtin_amdgcn_readfirstlane(tid>>6);
  const bf16*Qw=Qu+(long)(wid*QBLK)*DM;
  const unsigned lds0=(unsigned)(uintptr_t)shm;
  float*wsf=(float*)(shm+LDS_WS)+wid*64;
  const bf16*ksrc=Kh+(long)lane*DM+wid*8;
  const bf16*vsrc=Vh+(long)(16*(wid&3)+(lane>>2))*DM+(wid>>2)*32+(lane&3)*8;
  const unsigned kdst=lds0+LDS_K+wid*1024, vdst=lds0+LDS_V+wid*1024;
  #define DMA_K(t,slot) glds16(ksrc+(long)(t)*KVBLK*DM,(unsigned)__builtin_amdgcn_readfirstlane(kdst+(slot)))
  #define DMA_V(t,slot) glds16(vsrc+(long)(t)*KVBLK*DM,(unsigned)__builtin_amdgcn_readfirstlane(vdst+(slot)))
  const int vb0=(int)(lds0+LDS_V)+((lane>>4)&1)*32+(lane&3)*8+(4*hi+((lane&15)>>2))*64;
  const char*Kbase=shm+LDS_K; bf16x8 kf[8];
  const lds_cptr shm3=(lds_cptr)shm; const lds_cptr kp0=shm3+LDS_K+hi*1024+r32*16; const lds_cptr vp0=shm3+LDS_V+((lane>>4)&1)*32+(lane&3)*8+(4*hi+((lane&15)>>2))*64;
  DMA_K(0,0);DMA_V(0,0);DMA_K(1,SLOTB);
  bf16x8 qr[4];
  #pragma unroll
  for(int d0=0;d0<4;++d0)qr[d0]=*reinterpret_cast<const bf16x8*>(&Qw[(long)r32*DM+d0*16+hi*8]);
  float mhat=0.f,l_reg=0.f;f32x16 o[2];o[0]=f32x16{};o[1]=f32x16{};f32x16 negm=f32x16{};
  if(MODE==1){ mhat=sink2; l_reg=hi?0.f:1.f; _Pragma("unroll") for(int r=0;r<16;++r)negm[r]=-sink2; }
  asm volatile("":"+v"(negm));
  const int qrel=wid*QBLK+r32;
  #define CMASK(P0,P1,t) do{ if(MODE==0){int jb_=(t)-(NT-4); if(jb_>=0)cmask(P0,P1,jb_,qrel,hi);} else smask(P0,P1,(t),qrel,hi,shift); }while(0)
  bool resc=false;
  #define START(P0,P1) do{ const float rm=rowmax(P0,P1); resc=false; \
    if(MODE==0 || __any(rm>(float)THRL)){ const float dl=(MODE==0)?rm:__builtin_fmaxf(rm,0.f); if(MODE==1)l_reg*=__builtin_amdgcn_exp2f(-dl); mhat=fadd_s(mhat,dl); \
      _Pragma("unroll") for(int r=0;r<16;++r){P0[r]=fsub_s(P0[r],dl);P1[r]=fsub_s(P1[r],dl);} \
      _Pragma("unroll") for(int r=0;r<16;++r)negm[r]=-mhat; asm volatile("":"+v"(negm)); } \
    _Pragma("unroll") for(int r=0;r<16;++r)P0[r]=__builtin_amdgcn_exp2f(P0[r]); }while(0)
  #define RESC() do{ if(resc){ asm volatile("s_waitcnt lgkmcnt(0)":::"memory"); \
      _Pragma("unroll") for(int d_=0;d_<2;++d_) _Pragma("unroll") for(int r=0;r<16;++r)o[d_][r]*=wsf[crow(r,hi)]; } }while(0)
  f32x16 pA0,pA1,pB0,pB1;
  int sl_prev=0,sl_cur=0,sl_next=SLOTB;
  #define ROT() do{sl_prev=sl_cur;sl_cur=sl_next;sl_next=(sl_next==(NSLOT-1)*SLOTB)?0:sl_next+SLOTB;}while(0)
  DMA_K(2,2*SLOTB);
  WAIT_BAR(3);
  qkt(pA0,pA1,Kbase,qr,negm,r32,hi);asm volatile("s_nop 15\n\ts_nop 7":"+v"(pA0),"+v"(pA1));CMASK(pA0,pA1,0);
  START(pA0,pA1);
  _Pragma("unroll") for(int r=0;r<16;++r)pA1[r]=__builtin_amdgcn_exp2f(pA1[r]);
  WAIT_BAR(0);
  DMA_K(3,0);DMA_V(1,SLOTB);
  ROT();
  kload8(kf,kp0+sl_cur);
  WAIT_BAR(2);
  s16x4 vlo[8],vhi[8]; u32x4 pw0,pw1,pw2,pw3;
  #define PKW(P,B) cvtpk_s(P[B],P[B+1])
  #define PAF(k) __builtin_bit_cast(bf16x8,pw##k)
  #define VFR(i) (bf16x8){vlo[i][0],vlo[i][1],vlo[i][2],vlo[i][3],vhi[i][0],vhi[i][1],vhi[i][2],vhi[i][3]}
  #define PIN(x) asm volatile("":"+v"(x))
  #define MX3(a,b,c) __builtin_fmaxf(__builtin_fmaxf((a),(b)),(c))
  #define GAPA(MF,A0,A1,A2,A3,W0,W1,PW) do{ MF; sacc+=A0; sacc+=A1; sacc+=A2; sacc+=A3; PIN(sacc); W0; W1; PIN(PW); SBAR(); }while(0)
  #define EX(v) __builtin_amdgcn_exp2f(v)
  #define GAPB(MF,X,B) do{ MF; X[B]=EX(X[B]); X[B+1]=EX(X[B+1]); X[B+2]=EX(X[B+2]); X[B+3]=EX(X[B+3]); PIN(X); SBAR(); }while(0)
  #define VRD(i) do{ vlo[i]=vtr(vp_+(((i)>>2)*4096+((i)&3)*1024)); vhi[i]=vtr(vp_+(((i)>>2)*4096+((i)&3)*1024+512)); }while(0)
  #define KRD(G,j) do{ if(G){ kload2(kf,kp0+sl_next,j); SBAR(); } }while(0)
  #define STEP(C0,C1,P0,P1,t,GK,GV,GL) do{ SBAR(); \
    const lds_cptr vp_=vp0+sl_prev; \
    VRD(0); SBAR(); float sacc=(P0[0]+P0[1]); \
    GAPA(C0=__builtin_amdgcn_mfma_f32_32x32x16_bf16(kf[0],qr[0],negm,0,0,0), P0[2],P0[3],P0[4],P0[5],     pw0[0]=PKW(P0,0), pw0[1]=PKW(P0,2), pw0); \
    VRD(4); SBAR(); GAPA(C1=__builtin_amdgcn_mfma_f32_32x32x16_bf16(kf[1],qr[0],negm,0,0,0), P0[6],P0[7],P0[8],P0[9],     pw0[2]=PKW(P0,4), pw0[3]=PKW(P0,6), pw0); \
    VRD(1); SBAR(); GAPA(C0=__builtin_amdgcn_mfma_f32_32x32x16_bf16(kf[2],qr[1],C0,0,0,0),   P0[10],P0[11],P0[12],P0[13], pw1[0]=PKW(P0,8), pw1[1]=PKW(P0,10), pw1); \
    VRD(5); SBAR(); GAPA(C1=__builtin_amdgcn_mfma_f32_32x32x16_bf16(kf[3],qr[1],C1,0,0,0),   P0[14],P0[15],P1[0],P1[1],   pw1[2]=PKW(P0,12),pw1[3]=PKW(P0,14), pw1); \
    VRD(2); SBAR(); GAPA(C0=__builtin_amdgcn_mfma_f32_32x32x16_bf16(kf[4],qr[2],C0,0,0,0),   P1[2],P1[3],P1[4],P1[5],     pw2[0]=PKW(P1,0), pw2[1]=PKW(P1,2), pw2); \
    VRD(6); SBAR(); GAPA(C1=__builtin_amdgcn_mfma_f32_32x32x16_bf16(kf[5],qr[2],C1,0,0,0),   P1[6],P1[7],P1[8],P1[9],     pw2[2]=PKW(P1,4), pw2[3]=PKW(P1,6), pw2); \
    VRD(3); SBAR(); GAPA(C0=__builtin_amdgcn_mfma_f32_32x32x16_bf16(kf[6],qr[3],C0,0,0,0),   P1[10],P1[11],P1[12],P1[13], pw3[0]=PKW(P1,8), pw3[1]=PKW(P1,10), pw3); \
    VRD(7); SBAR(); GAPA(C1=__builtin_amdgcn_mfma_f32_32x32x16_bf16(kf[7],qr[3],C1,0,0,0),   P1[14],P1[15],0.f,0.f,       pw3[2]=PKW(P1,12),pw3[3]=PKW(P1,14), pw3); \
    l_reg+=sacc; \
    if(GK){DMA_K((t)+3,sl_cur);} if(GV){DMA_V((t)+1,sl_next);} \
    CMASK(C0,C1,t); \
    { float a=MX3(C0[0],C0[1],C1[0]),b=MX3(C0[2],C0[3],C1[1]); a=MX3(a,C1[2],C1[3]); \
      _Pragma("unroll") for(int r=4;r<16;r+=4){a=MX3(a,C0[r],C0[r+1]);b=MX3(b,C0[r+2],C0[r+3]);a=MX3(a,C1[r],C1[r+1]);b=MX3(b,C1[r+2],C1[r+3]);} \
      float rm=__builtin_fmaxf(a,b); { auto rr=__builtin_amdgcn_permlane32_swap(__float_as_uint(rm),__float_as_uint(rm),false,false); rm=__builtin_fmaxf(__uint_as_float(rr[0]),__uint_as_float(rr[1])); } \
      resc=false; \
      if(__builtin_expect(__any(rm>(float)THRL),0)){ const float dl=__builtin_fmaxf(rm,0.f); mhat+=dl; \
        _Pragma("unroll") for(int r=0;r<16;++r){C0[r]-=dl;C1[r]-=dl;} \
        _Pragma("unroll") for(int r=0;r<16;++r)negm[r]=-mhat; asm volatile("":"+v"(negm)); \
        const float f=__builtin_amdgcn_exp2f(-dl); l_reg*=f; if(hi==0)wsf[r32]=f; resc=true; } } \
    SBAR(); \
    GAPB(o[0]=__builtin_amdgcn_mfma_f32_32x32x16_bf16(PAF(0),VFR(0),o[0],0,0,0), C0,0); \
    GAPB(o[1]=__builtin_amdgcn_mfma_f32_32x32x16_bf16(PAF(0),VFR(4),o[1],0,0,0), C0,4); \
    KRD(GL,0); GAPB(o[0]=__builtin_amdgcn_mfma_f32_32x32x16_bf16(PAF(1),VFR(1),o[0],0,0,0), C0,8); \
    KRD(GL,1); GAPB(o[1]=__builtin_amdgcn_mfma_f32_32x32x16_bf16(PAF(1),VFR(5),o[1],0,0,0), C0,12); \
    KRD(GL,2); GAPB(o[0]=__builtin_amdgcn_mfma_f32_32x32x16_bf16(PAF(2),VFR(2),o[0],0,0,0), C1,0); \
    KRD(GL,3); GAPB(o[1]=__builtin_amdgcn_mfma_f32_32x32x16_bf16(PAF(2),VFR(6),o[1],0,0,0), C1,4); \
    GAPB(o[0]=__builtin_amdgcn_mfma_f32_32x32x16_bf16(PAF(3),VFR(3),o[0],0,0,0), C1,8); \
    GAPB(o[1]=__builtin_amdgcn_mfma_f32_32x32x16_bf16(PAF(3),VFR(7),o[1],0,0,0), C1,12); \
    }while(0)
  int t=1;
  #undef CMASK
  #define CMASK(P0,P1,t) do{}while(0)
  for(;t+5<NT;t+=2){
    STEP(pB0,pB1,pA0,pA1,t,true,true,true);     WAIT_BAR(2); RESC(); ROT();
    STEP(pA0,pA1,pB0,pB1,t+1,true,true,true);   WAIT_BAR(2); RESC(); ROT();
  }
  #undef CMASK
  #define CMASK(P0,P1,t) do{ if(MODE==0){int jb_=(t)-(NT-4); if(jb_>=0)cmask(P0,P1,jb_,qrel,hi);} else smask(P0,P1,(t),qrel,hi,shift); }while(0)
  #define ENDW(tt) do{ if((tt)+3<NT){WAIT_BAR(2);} else if((tt)+2<NT){WAIT_BAR(1);} else {WAIT_BAR(0);} }while(0)
  for(;t+1<NT;t+=2){
    STEP(pB0,pB1,pA0,pA1,t,(t+3<NT),(t+1<NT),(t+1<NT));       ENDW(t);   RESC(); ROT();
    STEP(pA0,pA1,pB0,pB1,t+1,(t+4<NT),(t+2<NT),(t+2<NT));     ENDW(t+1); RESC(); ROT();
  }
  STEP(pB0,pB1,pA0,pA1,NT-1,false,false,false); RESC();
  { float sacc=pB0[0]+pB0[1]; _Pragma("unroll") for(int r=2;r<16;++r)sacc+=pB0[r]; _Pragma("unroll") for(int r=0;r<16;++r)sacc+=pB1[r]; l_reg+=sacc;
    pw0=(u32x4){PKW(pB0,0),PKW(pB0,2),PKW(pB0,4),PKW(pB0,6)};pw1=(u32x4){PKW(pB0,8),PKW(pB0,10),PKW(pB0,12),PKW(pB0,14)};pw2=(u32x4){PKW(pB1,0),PKW(pB1,2),PKW(pB1,4),PKW(pB1,6)};pw3=(u32x4){PKW(pB1,8),PKW(pB1,10),PKW(pB1,12),PKW(pB1,14)};
    SBAR(); pv(o,vb0+sl_cur,PAF(0),PAF(1),PAF(2),PAF(3)); }
  #undef PKW
  #undef PAF
  #undef VFR
  #undef PIN
  #undef MX3
  #undef GAPA
  #undef GAPB
  #undef EX
  #undef VRD
  #undef KRD
  #undef STEP
  #undef ENDW
  {auto rr=__builtin_amdgcn_permlane32_swap(__float_as_uint(l_reg),__float_as_uint(l_reg),false,false);l_reg=__uint_as_float(rr[0])+__uint_as_float(rr[1]);}
  if(hi==0)wsf[32+r32]=l_reg;asm volatile("s_waitcnt lgkmcnt(0)":::"memory");
  float rli[16];
  #pragma unroll
  for(int r=0;r<16;++r)rli[r]=__builtin_amdgcn_rcpf(wsf[32+crow(r,hi)]);
  bf16*Ow=Ou+(long)(wid*QBLK)*opitch;
  { bf16*stg=(bf16*)(shm+LDS_OST)+wid*2048;
    #pragma unroll
    for(int r=0;r<16;++r){const int orow=crow(r,hi);
      #pragma unroll
      for(int d0=0;d0<2;++d0)stg[orow*64+d0*32+r32]=(bf16)(cvtpk_s(o[d0][r]*rli[r],0.f)&0xffffu);}
    asm volatile("s_waitcnt lgkmcnt(0)":::"memory");
    #pragma unroll
    for(int i=0;i<4;++i){const int row=i*8+(lane>>3),ch=lane&7; const u32x4 v=*(const u32x4*)(stg+row*64+ch*8); ATTN_STORE16(Ow+(long)row*opitch+ch*8,v);} }
  asm volatile("s_waitcnt lgkmcnt(0)\n\ts_barrier":::"memory");
  #undef DMA_K
  #undef DMA_V
  #undef CMASK
  #undef START
  #undef RESC
  #undef ROT
}
constexpr int ATTN_LDS_BYTES=LDS_BYTES;
#undef SBAR
#undef WAIT_BAR
}
constexpr int NWAVES = 8;
constexpr int RING_BYTES = 131072;
constexpr int TBL_OFF = 140 * 1024;
constexpr int MISC_OFF = 143 * 1024;
constexpr int LDS_BYTES = 147456;
static_assert(ROUTER_LDS <= TBL_OFF && attn_body::ATTN_LDS_BYTES <= RING_BYTES, "LDS map");
constexpr int CW_BAR = 4096;
constexpr int MAX_LAUNCHES = 12;

#define GAS __attribute__((address_space(1)))
#define LAS __attribute__((address_space(3)))
typedef GAS unsigned gu32;
#define RLX_AGENT __ATOMIC_RELAXED, __HIP_MEMORY_SCOPE_AGENT
#define XB_TMO      128
#define XB_XCNT(j)  (256  + 64 * (j))
#define XB_XSUB(j)  (1280 + 64 * (j))
#define XB_XGEN(j)  (2304 + 64 * (j))
#define XB_TOP      3328
#define XB_TOPGEN   3392
#define XCD_BAR_WORDS 3456
#define XB_SPIN_CAP (1u << 18)

__device__ __forceinline__ unsigned xb_ld(unsigned* p)              { return __hip_atomic_load(p, __ATOMIC_RELAXED, __HIP_MEMORY_SCOPE_AGENT); }
__device__ __forceinline__ unsigned xb_add(unsigned* p, unsigned v) { return __hip_atomic_fetch_add(p, v, __ATOMIC_RELAXED, __HIP_MEMORY_SCOPE_AGENT); }
__device__ __forceinline__ unsigned xb_xcc_id() { return (unsigned)__builtin_amdgcn_s_getreg((3 << 11) | 20) & 0xFu; }
#define XB_SPIN(cond, bar) do { unsigned _sp = 0; while (cond) { __builtin_amdgcn_s_sleep(1); \
    if ((++_sp & 255u) == 0u) { if (xb_ld(&(bar)[XB_TMO])) break; if (_sp > XB_SPIN_CAP) { atomicAdd(&(bar)[XB_TMO], 1u); break; } } } } while (0)

struct XcdBarrier {
    unsigned* bar; unsigned x;
    volatile LAS unsigned* st;
};

__device__ __forceinline__ XcdBarrier xcd_barrier_post(unsigned* bar, volatile LAS unsigned* st) {
    XcdBarrier b; b.bar = bar; b.x = xb_xcc_id(); b.st = st;
    if (threadIdx.x == 0) (void)xb_add(&bar[XB_XCNT(b.x)], 1u);
    return b;
}
__device__ __forceinline__ void xcd_barrier_complete(unsigned* bar, unsigned x, unsigned& nloc, unsigned& nx) {
    const unsigned G = gridDim.x * gridDim.y * gridDim.z;
    unsigned sum, cnt, mine, sp = 0u;
    for (;;) {
        sum = 0u; cnt = 0u; mine = 0u;
#pragma unroll
        for (unsigned j = 0; j < 16; ++j) { const unsigned c = xb_ld(&bar[XB_XCNT(j)]); sum += c; cnt += (c > 0u) ? 1u : 0u; mine = (j == x) ? c : mine; }
        if (sum == G) break;
        __builtin_amdgcn_s_sleep(1);
        if ((++sp & 255u) == 0u) { if (xb_ld(&bar[XB_TMO])) break; if (sp > XB_SPIN_CAP) { atomicAdd(&bar[XB_TMO], 1u); break; } }
    }
    nloc = mine > 0u ? mine : 1u; nx = cnt > 0u ? cnt : 1u;
}

__device__ __forceinline__ void xcd_barrier(const XcdBarrier& b) {
    asm volatile("s_waitcnt vmcnt(0)" ::: "memory");
    __syncthreads();
    if (threadIdx.x == 0) {
        unsigned* bar = b.bar;
        __builtin_amdgcn_s_waitcnt(0);
        unsigned nloc = b.st[0], nx = b.st[1];
        if (nloc == 0u) { xcd_barrier_complete(bar, b.x, nloc, nx); b.st[0] = nloc; b.st[1] = nx; }
        const unsigned old = xb_add(&bar[XB_XSUB(b.x)], 1u);
        const unsigned gen = old / nloc;
        if (old + 1u == (gen + 1u) * nloc) {
            __builtin_amdgcn_fence(__ATOMIC_RELEASE, "agent");
            asm volatile("s_waitcnt vmcnt(0)" ::: "memory");
            const unsigned og = xb_add(&bar[XB_TOP], 1u);
            const unsigned tg = og / nx;
            if (og + 1u == (tg + 1u) * nx) xb_add(&bar[XB_TOPGEN], 1u);
            else XB_SPIN(xb_ld(&bar[XB_TOPGEN]) == tg, bar);
            __builtin_amdgcn_fence(__ATOMIC_ACQUIRE, "agent");
            xb_add(&bar[XB_XGEN(b.x)], 1u);
            asm volatile("s_waitcnt vmcnt(0)" ::: "memory");
        } else {
            XB_SPIN(xb_ld(&bar[XB_XGEN(b.x)]) == gen, bar);
            __builtin_amdgcn_fence(__ATOMIC_ACQUIRE, "agent");
            asm volatile("s_waitcnt vmcnt(0)" ::: "memory");
        }
    }
    __syncthreads();
}


static_assert((CW_BAR + MAX_LAUNCHES * XCD_BAR_WORDS) * 4 <= (int)CTL_ZERO_BYTES, "barrier words inside the memset region");

__device__ __forceinline__ void phase_inproj(const Params& p, LAS unsigned char* lds, int G, int bid) {
    pg8::Gemm g{(const bf16_t*)(p.ws + WS_H1), (const bf16_t*)(p.ws + WS_WIN), DM, 0};
    pg8::StaticOrder S; S.init(NTOK, NPROJ, G, bid);
    pg8::EpiProj E{(bf16_t*)(p.ws + WS_PROJ), (const float*)(p.ws + WS_BINP), (const float*)(p.ws + WS_ROPE), (const float*)(p.ws + WS_ROPE) + (size_t)NTOK * 32};
    pg8::gemm_phase<pg8::EpiProj, pg8::StaticOrder, false>(lds, g, S, E);
}
__device__ __forceinline__ void phase_attn(const Params& p, char* lds, int G, int bid) {
    const int vcu = (G % 8 == 0) ? (bid % 8) * (G / 8) + bid / 8 : bid;
    const attn_body::bf16* proj = (const attn_body::bf16*)(p.ws + WS_PROJ);
    for (int v = vcu; v < 256; v += G) {
        const int bvh = v >> 3, s = v & 7, b = bvh >> 4, vh = bvh & 15, hm = vh >> 1, half = vh & 1;
        const attn_body::bf16* rowb = proj + (size_t)b * SEQ * NPROJ;
#pragma unroll 1
        for (int i = 0; i < 4; ++i) { const int qb = (i == 0) ? s : (i == 1) ? 15 - s : (i == 2) ? 16 + s : 31 - s;
            attn_body::attn_unit<8, 0>(rowb + (size_t)qb * 256 * NPROJ + PC_QD + hm * 64, rowb + PC_KD + hm * 64, rowb + PC_VD + (hm >> 1) * 128 + half * 64,
                                       (attn_body::bf16*)(p.ws + WS_OV) + ((size_t)b * SEQ + qb * 256) * DM + vh * 64, DM, 4 * (qb + 1), 0, 0.f, lds); }
    }
#pragma unroll 1
    for (int w = vcu; w < 512; w += G) {
        const int b = w >> 8, hq = (w >> 5) & 7, qb = w & 31, shift = qb ? 128 : 0;
        const attn_body::bf16* rowb = proj + (size_t)b * SEQ * NPROJ; const size_t krow = (size_t)(qb * 256 - shift) * NPROJ;
        attn_body::attn_unit<8, 1>(rowb + (size_t)qb * 256 * NPROJ + PC_QA + hq * 64, rowb + krow + PC_KA + (hq >> 2) * 64, rowb + krow + PC_VA + (hq >> 2) * 64,
                                   (attn_body::bf16*)(p.ws + WS_MIXED) + ((size_t)b * SEQ + qb * 256) * DM + hq * 64, DM, qb ? 6 : 4, shift, p.sinks[hq] * LOG2E, lds);
    }
}
__device__ __forceinline__ void phase_outproj(const Params& p, LAS unsigned char* lds, int G, int bid) {
    pg8::Gemm g{(const bf16_t*)(p.ws + WS_MIXED), (const bf16_t*)(p.ws + WS_WOUT), DM, 0};
    pg8::StaticOrder S; S.init(NTOK, DM, G, bid);
    pg8::EpiX1 E{p.x, (const float*)(p.ws + WS_MOD), p.b_out, (float*)(p.ws + WS_X1)};
    pg8::gemm_phase<pg8::EpiX1, pg8::StaticOrder, false>(lds, g, S, E);
}
__device__ __forceinline__ void build_tile_table(const Params& p, LAS unsigned char* lds) {
    LAS int* tb = (LAS int*)(lds + TBL_OFF); LAS int* cn = (LAS int*)(lds + TBL_OFF + 256);
    const unsigned* cnt = (const unsigned*)(p.ws + WS_CTL) + CW_CNT;
    __syncthreads();
    if (threadIdx.x == 0) { int a = 0; for (int e = 0; e < NEXP; ++e) { const int c = (int)__hip_atomic_load(cnt + e, RLX_AGENT); tb[e] = a; cn[e] = c; a += (c + 255) >> 8; } tb[NEXP] = a; }
    __syncthreads();
}
__device__ __forceinline__ void phase_gemm1(const Params& p, LAS unsigned char* lds, int G, int bid) {
    build_tile_table(p, lds);
    pg8::Gemm g{(const bf16_t*)(p.ws + WS_H2), (const bf16_t*)(p.ws + WS_W1), DM, (size_t)2 * DFF * DM};
    pg8::GroupedOrder S; S.init((const LAS int*)(lds + TBL_OFF), (const LAS int*)(lds + TBL_OFF + 256), (const int*)(p.ws + WS_LIST), 2 * DFF / 256, G, bid);
    pg8::EpiSwiglu E{p.b1, (bf16_t*)(p.ws + WS_ACT)};
    pg8::gemm_phase<pg8::EpiSwiglu, pg8::GroupedOrder, true>(lds, g, S, E);
}
__device__ __forceinline__ void phase_gemm2(const Params& p, LAS unsigned char* lds, int G, int bid) {
    build_tile_table(p, lds);
    pg8::Gemm g{(const bf16_t*)(p.ws + WS_ACT), (const bf16_t*)(p.ws + WS_W2), DFF, (size_t)DM * DFF};
    pg8::GroupedOrder S; S.init((const LAS int*)(lds + TBL_OFF), (const LAS int*)(lds + TBL_OFF + 256), (const int*)(p.ws + WS_LIST), DM / 256, G, bid);
    pg8::EpiY E{p.b2, (bf16_t*)(p.ws + WS_Y)};
    pg8::gemm_phase<pg8::EpiY, pg8::GroupedOrder, false>(lds, g, S, E);
}

constexpr int NPHASE = 10;
struct Args { Params p; int ph_lo, ph_hi, li, pad; };
__global__ void __launch_bounds__(NWAVES * 64, 2) mega(Args args) {
    extern __shared__ __attribute__((aligned(16))) unsigned char lds[];
    const Params& p = args.p;
    LAS unsigned char* L = (LAS unsigned char*)lds;
    volatile LAS unsigned* MISC = (volatile LAS unsigned*)(L + MISC_OFF);
    const int tid = threadIdx.x, G = gridDim.x, bid = blockIdx.x;
    for (int u = tid; u < (LDS_BYTES - MISC_OFF) / 4; u += NWAVES * 64) ((LAS unsigned*)(L + MISC_OFF))[u] = 0u;
    __syncthreads();
    XcdBarrier bar = xcd_barrier_post((unsigned*)(p.ws + WS_CTL) + CW_BAR + args.li * XCD_BAR_WORDS, MISC + 8);
    const int lo = args.ph_lo, hi = args.ph_hi;
#ifndef CMASKP
#define CMASKP 0x3ff
#endif
#define IN(k) (((CMASKP >> (k)) & 1) && lo <= (k) && (k) < hi)
#define SEAM(k) do { if (IN(k) && IN((k) + 1)) xcd_barrier(bar); } while (0)
    if (IN(0)) { phase_prep(p, bid, G, (float*)lds); } SEAM(0);
    if (IN(1)) { phase_h1(p, bid, G); } SEAM(1);
    if (IN(2)) { phase_inproj(p, L, G, bid); } SEAM(2);
    if (IN(3)) { phase_attn(p, (char*)lds, G, bid); } SEAM(3);
    if (IN(4)) { phase_combine(p, bid, G); } SEAM(4);
    if (IN(5)) { phase_outproj(p, L, G, bid); } SEAM(5);
    if (IN(6)) { phase_router(p, bid, G, lds); } SEAM(6);
    if (IN(7)) { phase_gemm1(p, L, G, bid); } SEAM(7);
    if (IN(8)) { phase_gemm2(p, L, G, bid); } SEAM(8);
    if (IN(9)) { phase_final(p, bid, G); }
#undef IN
#undef SEAM
}

template <class Epi>
__global__ __launch_bounds__(256) void ngemm(const bf16_t* __restrict__ A, const bf16_t* __restrict__ Bt, int K, const int* __restrict__ rowmap,
                                             const int* __restrict__ tiles, size_t bstride, Epi epi) {
    __shared__ __attribute__((aligned(16))) bf16_t sA[64][40];
    __shared__ __attribute__((aligned(16))) bf16_t sB[64][40];
    const int bm = blockIdx.y * 64, bn = blockIdx.x * 64, tid = threadIdx.x, lane = tid & 63, w = tid >> 6, wr = w >> 1, wc = w & 1, fr = lane & 15, quad = lane >> 4;
    int expert = 0;
    if (tiles) { if (bm / 256 >= tiles[0]) return; expert = tiles[16 + bm / 256]; }
    const bf16_t* Bb = Bt + (size_t)expert * bstride;
    const int lr = tid >> 2, lc = (tid & 3) * 8;
    const int arow = rowmap ? rowmap[bm + lr] : bm + lr;
    const bf16_t* ap = A + (size_t)arow * K + lc; const bf16_t* bp = Bb + (size_t)(bn + lr) * K + lc;
    f32x4 acc[2][2];
#pragma unroll
    for (int i = 0; i < 2; ++i)
#pragma unroll
        for (int j = 0; j < 2; ++j) acc[i][j] = (f32x4){0.f, 0.f, 0.f, 0.f};
    for (int k0 = 0; k0 < K; k0 += 32) {
        *(u32x4*)&sA[lr][lc] = *(const u32x4*)(ap + k0); *(u32x4*)&sB[lr][lc] = *(const u32x4*)(bp + k0);
        __syncthreads();
        bf16x8 a[2], b[2];
#pragma unroll
        for (int i = 0; i < 2; ++i) { a[i] = *(const bf16x8*)&sA[wr * 32 + i * 16 + fr][quad * 8]; b[i] = *(const bf16x8*)&sB[wc * 32 + i * 16 + fr][quad * 8]; }
#pragma unroll
        for (int i = 0; i < 2; ++i)
#pragma unroll
            for (int j = 0; j < 2; ++j) acc[i][j] = __builtin_amdgcn_mfma_f32_16x16x32_bf16(a[i], b[j], acc[i][j], 0, 0, 0);
        __syncthreads();
    }
#pragma unroll
    for (int i = 0; i < 2; ++i)
#pragma unroll
        for (int j = 0; j < 2; ++j)
#pragma unroll
            for (int r = 0; r < 4; ++r) epi(bm + wr * 32 + i * 16 + quad * 4 + r, bn + wc * 32 + j * 16 + fr, acc[i][j][r], expert);
}
struct EpiProjN {
    const float* bias; const float* ropec; const float* ropes; bf16_t* out;
    __device__ __forceinline__ void operator()(int row, int col, float v, int) const {
        v += bias[col];
        const float other = __shfl_xor(v, 1);
        if (col < PC_ROPE_END) { const int f = (col & 63) >> 1; const float c = ropec[row * 32 + f], s = ropes[row * 32 + f];
            v = (col & 1) ? (v * c + other * s) : (v * c - other * s);
            if (col < PC_KA || (col >= PC_QD && col < PC_KD)) v *= C2; }
        out[(size_t)row * NPROJ + col] = (bf16_t)f2bf(v);
    }
};
struct EpiX1N {
    const float* x; const float* mod; const float* bias; float* out;
    __device__ __forceinline__ void operator()(int row, int col, float v, int) const {
        const int b = row / SEQ; out[(size_t)row * DM + col] = x[(size_t)row * DM + col] + mod[b * (NMOD * DM) + 2 * DM + col] * (v + bias[col]);
    }
};
struct EpiSwigluN {
    const float* b1; bf16_t* act;
    __device__ __forceinline__ void operator()(int row, int col, float v, int e) const {
        v += b1[(size_t)e * 2 * DFF + col];
        const float other = __shfl_xor(v, 1);
        if (!(col & 1)) { const float g = fminf(v, 7.0f), l = fminf(fmaxf(other, -7.0f), 7.0f);
            act[(size_t)row * DFF + (col >> 1)] = (bf16_t)f2bf(g / (1.0f + __expf(-1.702f * g)) * (l + 1.0f)); }
    }
};
struct EpiYN {
    const float* b2; bf16_t* y;
    __device__ __forceinline__ void operator()(int row, int col, float v, int e) const { y[(size_t)row * DM + col] = (bf16_t)f2bf(v + b2[(size_t)e * DM + col]); }
};

template <int MODE>
__global__ __launch_bounds__(64) void nattn(const bf16_t* __restrict__ proj, bf16_t* __restrict__ out, const float* __restrict__ sinks) {
    const int lane = threadIdx.x, row = blockIdx.x * 64 + lane, t = row % SEQ, rowb = row - t, t0 = (blockIdx.x * 64) % SEQ, hd = blockIdx.y;
    int qcol, kcol, vcol, ocol, opitch;
    if (MODE == 0) { const int hm = hd >> 1, half = hd & 1; qcol = PC_QD + hm * 64; kcol = PC_KD + hm * 64; vcol = PC_VD + (hm >> 1) * 128 + half * 64; ocol = hd * 64; opitch = DM; }
    else { qcol = PC_QA + hd * 64; kcol = PC_KA + (hd >> 2) * 64; vcol = PC_VA + (hd >> 2) * 64; ocol = hd * 64; opitch = DM; }
    float q[64], o[64];
#pragma unroll
    for (int i = 0; i < 8; ++i) { const u32x4 w = *(const u32x4*)(proj + (size_t)row * NPROJ + qcol + i * 8);
#pragma unroll
        for (int j = 0; j < 4; ++j) { q[i * 8 + 2 * j] = bflo(w[j]); q[i * 8 + 2 * j + 1] = bfhi(w[j]); } }
#pragma unroll
    for (int i = 0; i < 64; ++i) o[i] = 0.f;
    float m, l;
    if (MODE == 1) { m = sinks[hd] * LOG2E; l = 1.0f; } else { m = -INFINITY; l = 0.f; }
    const int jlo = MODE == 1 ? (t0 - 127 < 0 ? 0 : t0 - 127) : 0, jhi = t0 + 63;
    for (int j = jlo; j <= jhi; ++j) {
        const bf16_t* kr = proj + (size_t)(rowb + j) * NPROJ + kcol; const bf16_t* vr = proj + (size_t)(rowb + j) * NPROJ + vcol;
        float s = 0.f;
#pragma unroll
        for (int i = 0; i < 8; ++i) { const u32x4 w = *(const u32x4*)(kr + i * 8);
#pragma unroll
            for (int jj = 0; jj < 4; ++jj) { s += q[i * 8 + 2 * jj] * bflo(w[jj]); s += q[i * 8 + 2 * jj + 1] * bfhi(w[jj]); } }
        const bool vis = (j <= t) && (MODE == 0 || (t - j) < 128);
        if (!vis) s = -INFINITY;
        const float mn = fmaxf(m, s);
        if (mn == -INFINITY) continue;
        const float alpha = exp2f(m - mn), pj = exp2f(s - mn);
        l = l * alpha + pj; m = mn;
#pragma unroll
        for (int i = 0; i < 8; ++i) { const u32x4 w = *(const u32x4*)(vr + i * 8);
#pragma unroll
            for (int jj = 0; jj < 4; ++jj) { o[i * 8 + 2 * jj] = o[i * 8 + 2 * jj] * alpha + pj * bflo(w[jj]); o[i * 8 + 2 * jj + 1] = o[i * 8 + 2 * jj + 1] * alpha + pj * bfhi(w[jj]); } }
    }
    const float rl = 1.0f / l;
#pragma unroll
    for (int i = 0; i < 8; ++i) { u32x4 w;
#pragma unroll
        for (int jj = 0; jj < 4; ++jj) w[jj] = pk2(o[i * 8 + 2 * jj] * rl, o[i * 8 + 2 * jj + 1] * rl);
        *(u32x4*)(out + (size_t)row * opitch + ocol + i * 8) = w; }
}

__global__ void k_tiles(Params p) {
    const unsigned* cnt = (const unsigned*)(p.ws + WS_CTL) + CW_CNT; int* tl = (int*)(p.ws + WS_TILES); int* rowmap = (int*)(p.ws + WS_ROWMAP); const int* list = (const int*)(p.ws + WS_LIST);
    __shared__ int tb[33];
    if (threadIdx.x == 0) { int a = 0; for (int e = 0; e < 32; ++e) { tb[e] = a; a += (int)((cnt[e] + 255u) >> 8); } tb[32] = a; tl[0] = a; }
    __syncthreads();
    for (int t = blockIdx.x; t < tb[32]; t += gridDim.x) {
        int e = 0; while (t >= tb[e + 1]) ++e;
        const int mt = t - tb[e];
        if (threadIdx.x == 0) { tl[16 + t] = e; tl[512 + t] = mt; }
        for (int r = threadIdx.x; r < 256; r += blockDim.x) { const int pos = mt * 256 + r; rowmap[t * 256 + r] = pos < (int)cnt[e] ? list[e * NTOK + pos] : 0; }
    }
}


#ifndef FAST_MASK
#define FAST_MASK 0x3ff
#endif
#ifndef SINGLE
#define SINGLE 1
#endif
extern "C" void kernel_launch(void* const* d_in, const int* in_sizes, int n_in, void* d_out, int out_size, void* d_ws, size_t ws_size, hipStream_t stream) {
    static int grid = 0;
    if (grid == 0) {
        if (n_in != 24 || in_sizes[0] != NTOK * DM || out_size != NTOK * DM || ws_size < WS_END) { fprintf(stderr, "kernel_launch: unexpected shapes (n_in %d in0 %d out %d ws %zu)\n", n_in, n_in > 0 ? in_sizes[0] : -1, out_size, ws_size); grid = -1; return; }
        int dev = 0, cus = 0, per_cu = 0;
        if (hipGetDevice(&dev) != hipSuccess || hipDeviceGetAttribute(&cus, hipDeviceAttributeMultiprocessorCount, dev) != hipSuccess) { fprintf(stderr, "kernel_launch: device query failed\n"); grid = -1; return; }
        if (hipFuncSetAttribute((const void*)mega, hipFuncAttributeMaxDynamicSharedMemorySize, LDS_BYTES) != hipSuccess) { fprintf(stderr, "kernel_launch: hipFuncSetAttribute(mega) failed\n"); grid = -1; return; }
        if (hipOccupancyMaxActiveBlocksPerMultiprocessor(&per_cu, (const void*)mega, NWAVES * 64, LDS_BYTES) != hipSuccess || per_cu < 1) { fprintf(stderr, "kernel_launch: occupancy query says %d blocks per CU\n", per_cu); }
        (void)hipGetLastError();
        grid = cus;
    }
    if (grid < 0) return;
    Params p{};
    p.x = (const float*)d_in[0]; p.c = (const float*)d_in[1]; p.pos = (const int*)d_in[2]; p.w_ada = (const float*)d_in[3]; p.b_ada = (const float*)d_in[4]; p.g_mix = (const float*)d_in[5];
    p.w_in = (const float*)d_in[6]; p.b_in = (const float*)d_in[7]; p.sinks = (const float*)d_in[8]; p.lq1 = (const float*)d_in[9]; p.lk1 = (const float*)d_in[10]; p.lq2 = (const float*)d_in[11];
    p.lk2 = (const float*)d_in[12]; p.g_subln = (const float*)d_in[13]; p.w_out = (const float*)d_in[14]; p.b_out = (const float*)d_in[15]; p.g_ffn = (const float*)d_in[16];
    p.w_router = (const float*)d_in[17]; p.b_router = (const float*)d_in[18]; p.w1 = (const float*)d_in[19]; p.b1 = (const float*)d_in[20]; p.w2 = (const float*)d_in[21]; p.b2 = (const float*)d_in[22];
    p.g_final = (const float*)d_in[23]; p.out = (float*)d_out; p.ws = (unsigned char*)d_ws;
    unsigned char* ws = p.ws;
    (void)hipMemsetAsync(ws + WS_CTL, 0, CTL_ZERO_BYTES, stream);
    int li = 0;
    auto launch_mega = [&](int lo, int hi) { Args a{}; a.p = p; a.ph_lo = lo; a.ph_hi = hi; a.li = li++; hipLaunchKernelGGL(mega, dim3(grid), dim3(NWAVES * 64), LDS_BYTES, stream, a); };
    if (FAST_MASK == 0x3ff && SINGLE) { launch_mega(0, NPHASE); return; }
    bool tiles_done = false;
    for (int k = 0; k < NPHASE; ++k) {
        if ((FAST_MASK >> k) & 1) { launch_mega(k, k + 1); continue; }
        if ((k == 7 || k == 8) && !tiles_done) { hipLaunchKernelGGL(k_tiles, dim3(MAXTILES), dim3(256), 0, stream, p); tiles_done = true; }
        switch (k) {
        case 2: { EpiProjN e{(const float*)(ws + WS_BINP), (const float*)(ws + WS_ROPE), (const float*)(ws + WS_ROPE) + (size_t)NTOK * 32, (bf16_t*)(ws + WS_PROJ)};
            hipLaunchKernelGGL(ngemm<EpiProjN>, dim3(NPROJ / 64, NTOK / 64), dim3(256), 0, stream, (const bf16_t*)(ws + WS_H1), (const bf16_t*)(ws + WS_WIN), DM, (const int*)nullptr, (const int*)nullptr, (size_t)0, e); } break;
        case 3: hipLaunchKernelGGL(nattn<1>, dim3(NTOK / 64, 8), dim3(64), 0, stream, (const bf16_t*)(ws + WS_PROJ), (bf16_t*)(ws + WS_MIXED), p.sinks);
            hipLaunchKernelGGL(nattn<0>, dim3(NTOK / 64, 16), dim3(64), 0, stream, (const bf16_t*)(ws + WS_PROJ), (bf16_t*)(ws + WS_OV), p.sinks); break;
        case 5: { EpiX1N e{p.x, (const float*)(ws + WS_MOD), p.b_out, (float*)(ws + WS_X1)};
            hipLaunchKernelGGL(ngemm<EpiX1N>, dim3(DM / 64, NTOK / 64), dim3(256), 0, stream, (const bf16_t*)(ws + WS_MIXED), (const bf16_t*)(ws + WS_WOUT), DM, (const int*)nullptr, (const int*)nullptr, (size_t)0, e); } break;
        case 7: { EpiSwigluN e{p.b1, (bf16_t*)(ws + WS_ACT)};
            hipLaunchKernelGGL(ngemm<EpiSwigluN>, dim3(2 * DFF / 64, MAXROWS / 64), dim3(256), 0, stream, (const bf16_t*)(ws + WS_H2), (const bf16_t*)(ws + WS_W1), DM, (const int*)(ws + WS_ROWMAP), (const int*)(ws + WS_TILES), (size_t)2 * DFF * DM, e); } break;
        case 8: { EpiYN e{p.b2, (bf16_t*)(ws + WS_Y)};
            hipLaunchKernelGGL(ngemm<EpiYN>, dim3(DM / 64, MAXROWS / 64), dim3(256), 0, stream, (const bf16_t*)(ws + WS_ACT), (const bf16_t*)(ws + WS_W2), DFF, (const int*)nullptr, (const int*)(ws + WS_TILES), (size_t)DM * DFF, e); } break;
        default: fprintf(stderr, "kernel_launch: phase %d has no naive form\n", k); break;
        }
    }
}
```

```cpp
#include <hip/hip_runtime.h>
#include <cstdint>
#include <cstdio>

constexpr int BATCH = 2, SEQ = 8192, NTOK = BATCH * SEQ, DM = 1024, NPROJ = 2304, NEXP = 32, TOPK = 4, DFF = 1024, NMOD = 6;
constexpr float EPS = 1e-5f;
constexpr float C2 = 0.125f * 1.4426950408889634f;
constexpr float LOG2E = 1.4426950408889634f;
constexpr float LAMBDA_INIT = 0.2f;
constexpr int PC_QA = 0, PC_KA = 512, PC_QD = 640, PC_KD = 1152, PC_VA = 1664, PC_VD = 1792, PC_ROPE_END = 1664;
constexpr int MAXTILES = 288;
constexpr int MAXROWS = MAXTILES * 256;

constexpr size_t MiB = 1u << 20;
constexpr size_t WS_CTL = 0, CTL_ZERO_BYTES = 256 * 1024;
constexpr size_t WS_MOD = 1 * MiB;
constexpr size_t WS_BINP = WS_MOD + 64 * 1024;
constexpr size_t WS_LAM = WS_BINP + 16 * 1024;
constexpr size_t WS_TILES = WS_LAM + 1024;
constexpr size_t WS_WRT = WS_MOD + 128 * 1024;
constexpr size_t WS_GAM2 = WS_MOD + 256 * 1024;
constexpr size_t WS_CB = WS_GAM2 + 8 * 1024;
constexpr size_t WS_ROPE = 2 * MiB;
constexpr size_t WS_WIN = 8 * MiB;
constexpr size_t WS_WOUT = 14 * MiB;
constexpr size_t WS_W1 = 16 * MiB;
constexpr size_t WS_W2 = 144 * MiB;
constexpr size_t WS_H1 = 208 * MiB;
constexpr size_t WS_PROJ = 240 * MiB;
constexpr size_t WS_OV = 312 * MiB;
constexpr size_t WS_MIXED = 344 * MiB;
constexpr size_t WS_X1 = 376 * MiB;
constexpr size_t WS_H2 = 440 * MiB;
constexpr size_t WS_GATE = 474 * MiB;
constexpr size_t WS_TOKPOS = WS_GATE + 256 * 1024;
constexpr size_t WS_LIST = 475 * MiB;
constexpr size_t WS_ROWMAP = 478 * MiB;
constexpr size_t WS_ACT = 480 * MiB;
constexpr size_t WS_Y = 624 * MiB;
constexpr size_t WS_END = 768 * MiB;
constexpr int CW_CNT = 64;
constexpr int CW_W2CUR = 128;

__constant__ float ROPE_INV[32] = {
    1.000000000e+00f, 7.498942018e-01f, 5.623413324e-01f, 4.216965139e-01f, 3.162277639e-01f, 2.371373922e-01f, 1.778279394e-01f, 1.333521456e-01f,
    1.000000015e-01f, 7.498941571e-02f, 5.623412877e-02f, 4.216964915e-02f, 3.162277862e-02f, 2.371373586e-02f, 1.778279431e-02f, 1.333521493e-02f,
    9.999999776e-03f, 7.498942316e-03f, 5.623413250e-03f, 4.216964822e-03f, 3.162277862e-03f, 2.371373819e-03f, 1.778279431e-03f, 1.333521446e-03f,
    1.000000047e-03f, 7.498941850e-04f, 5.623413017e-04f, 4.216965463e-04f, 3.162277862e-04f, 2.371373848e-04f, 1.778279402e-04f, 1.333521504e-04f};
typedef unsigned short bf16_t;
typedef float f32x4 __attribute__((ext_vector_type(4)));
typedef short bf16x8 __attribute__((ext_vector_type(8)));
typedef unsigned u32x4 __attribute__((ext_vector_type(4)));
typedef unsigned u32x2 __attribute__((ext_vector_type(2)));

__device__ __forceinline__ unsigned f2bf(float f) { unsigned u = __float_as_uint(f); return (u + 0x7fffu + ((u >> 16) & 1u)) >> 16; }
__device__ __forceinline__ unsigned pk2(float lo, float hi) { return f2bf(lo) | (f2bf(hi) << 16); }
__device__ __forceinline__ float bf2f(unsigned h) { return __uint_as_float(h << 16); }
__device__ __forceinline__ float bflo(unsigned w) { return __uint_as_float(w << 16); }
__device__ __forceinline__ float bfhi(unsigned w) { return __uint_as_float(w & 0xffff0000u); }
__device__ __forceinline__ float wave_sum(float v) {
#pragma unroll
    for (int o = 1; o < 64; o <<= 1) v += __shfl_xor(v, o);
    return v;
}

struct Params {
    const float *x, *c; const int* pos; const float *w_ada, *b_ada, *g_mix, *w_in, *b_in, *sinks, *lq1, *lk1, *lq2, *lk2, *g_subln, *w_out, *b_out, *g_ffn,
        *w_router, *b_router, *w1, *b1, *w2, *b2, *g_final;
    float* out; unsigned char* ws;
};

__device__ __forceinline__ int proj_col_of_src(int s) {
    if (s < 640) { const int head = s >> 6, d = s & 63; return head * 64 + 2 * (d & 31) + (d >> 5); }
    if (s < 768) return PC_VA + (s - 640);
    if (s < 1792) { const int t = s - 768, head = t >> 6, d = t & 63; return PC_QD + head * 64 + 2 * (d & 31) + (d >> 5); }
    return s;
}

struct TItem { const float* src; bf16_t* dst; int N, K, n0; bool perm; };
constexpr int TI_IN = (DM / 64) * (NPROJ / 32), TI_OUT = (DM / 64) * (DM / 32), TI_W1 = (DM / 64) * (2 * DFF / 32), TI_W2 = (DFF / 64) * (DM / 32);
constexpr int TI_TOTAL = TI_IN + TI_OUT + NEXP * TI_W1 + NEXP * TI_W2;
constexpr int TI_W2_START = TI_IN + TI_OUT + NEXP * TI_W1, PREP_W2_ITEMS = 2048, W2_CHUNK = 48;
__device__ __forceinline__ TItem titem_decode(const Params& p, int it, int lane) {
    const float* W; bf16_t* WT; int K, N; bool perm = false; int r = it;
    if (r < TI_IN) { W = p.w_in; WT = (bf16_t*)(p.ws + WS_WIN); K = DM; N = NPROJ; perm = true; }
    else if ((r -= TI_IN) < TI_OUT) { W = p.w_out; WT = (bf16_t*)(p.ws + WS_WOUT); K = DM; N = DM; }
    else if ((r -= TI_OUT) < NEXP * TI_W1) { const int e = r / TI_W1; r -= e * TI_W1; W = p.w1 + (size_t)e * DM * 2 * DFF; WT = (bf16_t*)(p.ws + WS_W1) + (size_t)e * 2 * DFF * DM; K = DM; N = 2 * DFF; }
    else { r -= NEXP * TI_W1; const int e = r / TI_W2; r -= e * TI_W2; W = p.w2 + (size_t)e * DFF * DM; WT = (bf16_t*)(p.ws + WS_W2) + (size_t)e * DM * DFF; K = DFF; N = DM; }
    const int nblk = N / 32, kb = r / nblk, nb = r - kb * nblk, k0 = 64 * kb + 8 * (lane >> 3), n0 = 32 * nb + 4 * (lane & 7);
    TItem t; t.src = W + (size_t)k0 * N + n0; t.dst = WT + k0; t.N = N; t.K = K; t.n0 = n0; t.perm = perm; return t;
}
__device__ __forceinline__ void titem_load(const TItem& t, f32x4 (&v)[16]) {
#pragma unroll
    for (int kk = 0; kk < 8; ++kk) { v[kk] = __builtin_nontemporal_load((const f32x4*)(t.src + (size_t)kk * t.N)); v[8 + kk] = __builtin_nontemporal_load((const f32x4*)(t.src + (size_t)kk * t.N + 32)); }
}
__device__ __forceinline__ void titem_store(const TItem& t, const f32x4 (&v)[16]) {
#pragma unroll
    for (int h = 0; h < 2; ++h)
#pragma unroll
        for (int i = 0; i < 4; ++i) {
            const int n = t.n0 + 32 * h + i, r = t.perm ? proj_col_of_src(n) : n;
            u32x4 o; o.x = pk2(v[8 * h + 0][i], v[8 * h + 1][i]); o.y = pk2(v[8 * h + 2][i], v[8 * h + 3][i]); o.z = pk2(v[8 * h + 4][i], v[8 * h + 5][i]); o.w = pk2(v[8 * h + 6][i], v[8 * h + 7][i]);
            *(u32x4*)(t.dst + (size_t)r * t.K) = o;
        }
}
__device__ __forceinline__ void transpose_items(const Params& p, int lo, int hi, int gw, int NGW, int lane) {
    int it = lo + 2 * gw; if (it >= hi) return;
    const int st = 2 * NGW;
    f32x4 va[16], vb[16]; TItem A = titem_decode(p, it, lane), B = A; titem_load(A, va);
    for (;;) {
        const bool hasB = it + st < hi; if (hasB) { B = titem_decode(p, it + st, lane); titem_load(B, vb); }
        titem_store(A, va); if (!hasB) break;
        const bool hasA = it + 2 * st < hi; if (hasA) { A = titem_decode(p, it + 2 * st, lane); titem_load(A, va); }
        titem_store(B, vb); if (!hasA) break;
        it += 2 * st;
    }
}

__device__ __forceinline__ void sincos_acc(float angf, float& s, float& c) {
    const double a = (double)angf;
    const double n = __builtin_rint(a * 0.63661977236758134308);
    double r = __builtin_fma(-n, 1.57079632679489655800e+00, a);
    r = __builtin_fma(-n, 6.12323399573676603587e-17, r);
    const double r2 = r * r;
    double sp = -2.5052108385441718775e-08; sp = sp * r2 + 2.7557319223985890653e-06; sp = sp * r2 - 1.9841269841269841253e-04; sp = sp * r2 + 8.3333333333333332177e-03;
    sp = sp * r2 - 1.6666666666666665741e-01; const double sn = r + r * r2 * sp;
    double cp = 2.0876756987868098979e-09; cp = cp * r2 - 2.7557319223985888276e-07; cp = cp * r2 + 2.4801587301587301566e-05; cp = cp * r2 - 1.3888888888888889419e-03;
    cp = cp * r2 + 4.1666666666666664354e-02; const double cs = 1.0 - 0.5 * r2 + r2 * r2 * cp;
    const int q = ((int)n) & 3;
    const double ss = (q & 1) ? cs : sn, cc = (q & 1) ? sn : cs;
    s = (float)((q & 2) ? -ss : ss); c = (float)(((q + 1) & 2) ? -cc : cc);
}

__device__ __forceinline__ void phase_prep(const Params& p, int bid, int nb, float* lds) {
    const int tid = threadIdx.x, lane = tid & 63, wave = tid >> 6;
    unsigned char* ws = p.ws;
    for (int jc = bid; jc < NMOD * DM / 64; jc += nb) {
        const int j = jc * 64 + lane; float a0 = 0.f, a1 = 0.f;
        for (int k = wave * 128; k < wave * 128 + 128; ++k) {
            const float c0 = p.c[k], c1 = p.c[DM + k];
            const float s0 = c0 / (1.f + __expf(-c0)), s1 = c1 / (1.f + __expf(-c1));
            const float w = p.w_ada[(size_t)k * (NMOD * DM) + j];
            a0 += s0 * w; a1 += s1 * w;
        }
        lds[(wave * 2 + 0) * 64 + lane] = a0; lds[(wave * 2 + 1) * 64 + lane] = a1;
        __syncthreads();
        if (wave < 2) { float s = 0.f;
#pragma unroll
            for (int w = 0; w < 8; ++w) s += lds[(w * 2 + wave) * 64 + lane];
            ((float*)(ws + WS_MOD))[wave * (NMOD * DM) + j] = s + p.b_ada[j]; }
        __syncthreads();
    }
    { float* ct = (float*)(ws + WS_ROPE); float* st = ct + (size_t)NTOK * 32;
        for (int i = bid * 512 + tid; i < NTOK * 32; i += nb * 512) {
            const int row = i >> 5, f = i & 31;
            const float ang = (float)p.pos[row] * ROPE_INV[f];
            float s, c; sincos_acc(ang, s, c); ct[i] = c; st[i] = s; } }
    if (bid == nb - 1) {
        float* bp = (float*)(ws + WS_BINP);
        for (int s = tid; s < NPROJ; s += 512) bp[proj_col_of_src(s)] = p.b_in[s];
        if (wave == 0) { const float a = wave_sum(p.lq1[lane] * p.lk1[lane]), b = wave_sum(p.lq2[lane] * p.lk2[lane]);
            if (lane == 0) *(float*)(ws + WS_LAM) = expf(a) - expf(b) + LAMBDA_INIT; }
    }
    for (int i = bid * 512 + tid; i < DM * NEXP; i += nb * 512) { const int k = i >> 5, e = i & 31; ((float*)(ws + WS_WRT))[e * DM + k] = p.w_router[i]; }
    transpose_items(p, 0, TI_W2_START + PREP_W2_ITEMS, bid * 8 + wave, nb * 8, lane);
}

__device__ __forceinline__ void norm_mod_row(const float* xrow, const float* g, const float* sc, const float* sh, bf16_t* orow, int lane) {
    f32x4 v[4]; float s = 0.f;
#pragma unroll
    for (int j = 0; j < 4; ++j) { v[j] = *(const f32x4*)(xrow + 4 * lane + 256 * j); s += (v[j].x * v[j].x + v[j].y * v[j].y) + (v[j].z * v[j].z + v[j].w * v[j].w); }
    const float rinv = 1.0f / sqrtf(wave_sum(s) * (1.f / DM) + EPS);
#pragma unroll
    for (int j = 0; j < 4; ++j) {
        const f32x4 gg = *(const f32x4*)(g + 4 * lane + 256 * j), cc = *(const f32x4*)(sc + 4 * lane + 256 * j), hh = *(const f32x4*)(sh + 4 * lane + 256 * j);
        const f32x4 o = v[j] * rinv * gg * (1.0f + cc) + hh;
        u32x2 w; w.x = pk2(o.x, o.y); w.y = pk2(o.z, o.w);
        *(u32x2*)(orow + 4 * lane + 256 * j) = w;
    }
}
__device__ __forceinline__ void phase_h1(const Params& p, int bid, int nb) {
    const int lane = threadIdx.x & 63, wave = threadIdx.x >> 6, gw = bid * 8 + wave, NGW = nb * 8;
    const float* mod = (const float*)(p.ws + WS_MOD);
    if (bid == nb - 1) {
        for (int i = threadIdx.x; i < 2 * DM; i += 512) { const int b = i >> 10, k = i & 1023; ((float*)(p.ws + WS_GAM2))[i] = p.g_ffn[k] * (1.0f + mod[b * (NMOD * DM) + 4 * DM + k]); }
        for (int pr = wave; pr < 2 * NEXP; pr += 8) { const int b = pr >> 5, e = pr & 31; float a = 0.f;
            for (int k = lane; k < DM; k += 64) a += mod[b * (NMOD * DM) + 3 * DM + k] * p.w_router[k * NEXP + e];
            a = wave_sum(a); if (lane == 0) ((float*)(p.ws + WS_CB))[pr] = a + p.b_router[e]; }
    }
    for (int m = gw; m < NTOK; m += NGW) { const int b = m / SEQ;
        norm_mod_row(p.x + (size_t)m * DM, p.g_mix, mod + b * (NMOD * DM) + 1 * DM, mod + b * (NMOD * DM) + 0 * DM, (bf16_t*)(p.ws + WS_H1) + (size_t)m * DM, lane); }
}

__device__ __forceinline__ void phase_combine(const Params& p, int bid, int nb) {
    const int lane = threadIdx.x & 63, wave = threadIdx.x >> 6, gw = bid * 8 + wave, NGW = nb * 8;
    const float lam = *(const float*)(p.ws + WS_LAM);
    const int h = lane >> 4, e0 = (lane & 15) * 8, half = e0 >> 6, d0 = e0 & 63;
    float g[8];
#pragma unroll
    for (int i = 0; i < 8; ++i) g[i] = p.g_subln[e0 + i] * (1.0f - LAMBDA_INIT);
    for (int m = gw; m < NTOK; m += NGW) {
        const bf16_t* ov = (const bf16_t*)(p.ws + WS_OV) + (size_t)m * DM;
        const u32x4 a = *(const u32x4*)(ov + ((h * 2 + 0) * 2 + half) * 64 + d0), b = *(const u32x4*)(ov + ((h * 2 + 1) * 2 + half) * 64 + d0);
        float o[8]; float s = 0.f;
#pragma unroll
        for (int i = 0; i < 4; ++i) { o[2 * i] = bflo(a[i]) - lam * bflo(b[i]); o[2 * i + 1] = bfhi(a[i]) - lam * bfhi(b[i]); }
#pragma unroll
        for (int i = 0; i < 8; ++i) s += o[i] * o[i];
        s += __shfl_xor(s, 1); s += __shfl_xor(s, 2); s += __shfl_xor(s, 4); s += __shfl_xor(s, 8);
        const float rinv = 1.0f / sqrtf(s * (1.f / 128.f) + EPS);
        u32x4 w; w.x = pk2(o[0] * rinv * g[0], o[1] * rinv * g[1]); w.y = pk2(o[2] * rinv * g[2], o[3] * rinv * g[3]);
        w.z = pk2(o[4] * rinv * g[4], o[5] * rinv * g[5]); w.w = pk2(o[6] * rinv * g[6], o[7] * rinv * g[7]);
        *(u32x4*)((bf16_t*)(p.ws + WS_MIXED) + (size_t)m * DM + 512 + h * 128 + e0) = w;
    }
}

typedef float f32x16 __attribute__((ext_vector_type(16)));
constexpr int ROUTER_LDS = 4 * 64 * 33 * 4 + 4 * 64 * 4 + 64 * 4 + 2048;
__device__ __forceinline__ void phase_router(const Params& p, int bid, int nb, unsigned char* ldsb) {
    const int tid = threadIdx.x, lane = tid & 63, wave = tid >> 6;
    float* P = (float*)ldsb; float* SS = P + 4 * 64 * 33; float* RI = SS + 256; int* hist = (int*)(RI + 64); int* gbase = hist + 32; int* rec = hist + 64;
    unsigned* cnt = (unsigned*)(p.ws + WS_CTL) + CW_CNT;
    const float* wrT = (const float*)(p.ws + WS_WRT); const float* mod = (const float*)(p.ws + WS_MOD); const float* X1 = (const float*)(p.ws + WS_X1);
    for (int r0 = bid * 64; r0 < NTOK; r0 += nb * 64) {
        const int b = r0 / SEQ; const float* gam = (const float*)(p.ws + WS_GAM2) + b * DM; const float* sh2 = mod + b * (NMOD * DM) + 3 * DM; const float* cb = (const float*)(p.ws + WS_CB) + b * NEXP;
        if (tid < 32) hist[tid] = 0;
        { const int rg = wave >> 2, kq = wave & 3, rr = lane & 31, hh = lane >> 5;
            const float* xr = X1 + (size_t)(r0 + rg * 32 + rr) * DM + kq * 256 + 4 * hh; const float* gr = gam + kq * 256 + 4 * hh; const float* wr = wrT + (size_t)rr * DM + kq * 256 + 4 * hh;
            f32x16 acc;
#pragma unroll
            for (int r = 0; r < 16; ++r) acc[r] = 0.f;
            float ss = 0.f;
#pragma unroll 8
            for (int i = 0; i < 32; ++i) {
                const f32x4 xv = *(const f32x4*)(xr + 8 * i), gv = *(const f32x4*)(gr + 8 * i), wv = *(const f32x4*)(wr + 8 * i);
                ss += (xv.x * xv.x + xv.y * xv.y) + (xv.z * xv.z + xv.w * xv.w);
                const f32x4 a = xv * gv;
                acc = __builtin_amdgcn_mfma_f32_32x32x2f32(a.x, wv.x, acc, 0, 0, 0); acc = __builtin_amdgcn_mfma_f32_32x32x2f32(a.y, wv.y, acc, 0, 0, 0);
                acc = __builtin_amdgcn_mfma_f32_32x32x2f32(a.z, wv.z, acc, 0, 0, 0); acc = __builtin_amdgcn_mfma_f32_32x32x2f32(a.w, wv.w, acc, 0, 0, 0);
            }
            ss += __shfl_xor(ss, 32);
            if (hh == 0) SS[kq * 64 + rg * 32 + rr] = ss;
#pragma unroll
            for (int r = 0; r < 16; ++r) P[(kq * 64 + rg * 32 + (r & 3) + 8 * (r >> 2) + 4 * hh) * 33 + rr] = acc[r];
        }
        __syncthreads();
        if (wave == 0) { const int m = r0 + lane;
            const float rinv = 1.0f / sqrtf(((SS[lane] + SS[64 + lane]) + (SS[128 + lane] + SS[192 + lane])) * (1.f / DM) + EPS); RI[lane] = rinv;
            float tv[4] = {-INFINITY, -INFINITY, -INFINITY, -INFINITY}; int ti[4] = {0, 0, 0, 0};
#pragma unroll
            for (int e = 0; e < 32; ++e) { const float val = rinv * ((P[lane * 33 + e] + P[(64 + lane) * 33 + e]) + (P[(128 + lane) * 33 + e] + P[(192 + lane) * 33 + e])) + cb[e];
                if (val > tv[3]) { tv[3] = val; ti[3] = e;
                    if (tv[3] > tv[2]) { float t = tv[2]; tv[2] = tv[3]; tv[3] = t; int q = ti[2]; ti[2] = ti[3]; ti[3] = q;
                        if (tv[2] > tv[1]) { t = tv[1]; tv[1] = tv[2]; tv[2] = t; q = ti[1]; ti[1] = ti[2]; ti[2] = q;
                            if (tv[1] > tv[0]) { t = tv[0]; tv[0] = tv[1]; tv[1] = t; q = ti[0]; ti[0] = ti[1]; ti[1] = q; } } } } }
            const float e1 = __expf(tv[1] - tv[0]), e2 = __expf(tv[2] - tv[0]), e3 = __expf(tv[3] - tv[0]); const float inv = 1.0f / (1.0f + e1 + e2 + e3);
            f32x4 gt; gt.x = inv; gt.y = e1 * inv; gt.z = e2 * inv; gt.w = e3 * inv;
            *(f32x4*)((float*)(p.ws + WS_GATE) + (size_t)m * 4) = gt;
#pragma unroll
            for (int k = 0; k < 4; ++k) { const int lp = atomicAdd(&hist[ti[k]], 1); rec[lane * 4 + k] = (ti[k] << 16) | lp; }
        }
        __syncthreads();
        if (tid < 32) gbase[tid] = (int)atomicAdd(&cnt[tid], (unsigned)hist[tid]);
        for (int rr = 0; rr < 8; ++rr) { const int lrow = wave * 8 + rr, m = r0 + lrow; const float rinv = RI[lrow];
            const float* xrow = X1 + (size_t)m * DM; bf16_t* orow = (bf16_t*)(p.ws + WS_H2) + (size_t)m * DM;
#pragma unroll
            for (int j = 0; j < 4; ++j) { const f32x4 xv = *(const f32x4*)(xrow + 4 * lane + 256 * j), gg = *(const f32x4*)(gam + 4 * lane + 256 * j), hh = *(const f32x4*)(sh2 + 4 * lane + 256 * j);
                const f32x4 o = xv * rinv * gg + hh; u32x2 w; w.x = pk2(o.x, o.y); w.y = pk2(o.z, o.w); *(u32x2*)(orow + 4 * lane + 256 * j) = w; } }
        __syncthreads();
        if (tid < 256) { const int lrow = tid >> 2, k = tid & 3, m = r0 + lrow; const int rc = rec[lrow * 4 + k], e = rc >> 16, pos = gbase[e] + (rc & 0xffff);
            ((int*)(p.ws + WS_LIST))[e * NTOK + pos] = m; ((int*)(p.ws + WS_TOKPOS))[(size_t)m * 4 + k] = e * NTOK + pos; }
        __syncthreads();
    }
}

__device__ __forceinline__ void phase_final(const Params& p, int bid, int nb) {
    const int lane = threadIdx.x & 63, wave = threadIdx.x >> 6, gw = bid * 8 + wave, NGW = nb * 8;
    const unsigned* cnt = (const unsigned*)(p.ws + WS_CTL) + CW_CNT;
    int mybase = 0; { int acc = 0; for (int e = 0; e < 32; ++e) { if (e == (lane & 31)) mybase = acc; acc += (int)((cnt[e] + 255u) >> 8) * 256; } }
    const float* mod = (const float*)(p.ws + WS_MOD);
    for (int m = gw; m < NTOK; m += NGW) {
        const int b = m / SEQ; const float* gt2 = mod + b * (NMOD * DM) + 5 * DM;
        const float* xrow = (const float*)(p.ws + WS_X1) + (size_t)m * DM;
        f32x4 acc[4];
#pragma unroll
        for (int j = 0; j < 4; ++j) acc[j] = (f32x4){0.f, 0.f, 0.f, 0.f};
#pragma unroll
        for (int k = 0; k < 4; ++k) {
            const int tp = ((const int*)(p.ws + WS_TOKPOS))[(size_t)m * 4 + k]; const float gk = ((const float*)(p.ws + WS_GATE))[(size_t)m * 4 + k];
            const int e = tp / NTOK, pos = tp % NTOK; const int row = __shfl(mybase, e) + pos;
            const bf16_t* yr = (const bf16_t*)(p.ws + WS_Y) + (size_t)row * DM;
#pragma unroll
            for (int j = 0; j < 4; ++j) { const u32x2 w = *(const u32x2*)(yr + 4 * lane + 256 * j);
                acc[j].x += gk * bflo(w.x); acc[j].y += gk * bfhi(w.x); acc[j].z += gk * bflo(w.y); acc[j].w += gk * bfhi(w.y); }
        }
        float s = 0.f;
#pragma unroll
        for (int j = 0; j < 4; ++j) { const f32x4 xv = *(const f32x4*)(xrow + 4 * lane + 256 * j), gg = *(const f32x4*)(gt2 + 4 * lane + 256 * j);
            acc[j] = xv + gg * acc[j]; s += (acc[j].x * acc[j].x + acc[j].y * acc[j].y) + (acc[j].z * acc[j].z + acc[j].w * acc[j].w); }
        const float rinv = 1.0f / sqrtf(wave_sum(s) * (1.f / DM) + EPS);
#pragma unroll
        for (int j = 0; j < 4; ++j) { const f32x4 gf = *(const f32x4*)(p.g_final + 4 * lane + 256 * j);
            *(f32x4*)(p.out + (size_t)m * DM + 4 * lane + 256 * j) = acc[j] * rinv * gf; }
    }
}

namespace pg8 {
#define PG8_LAS __attribute__((address_space(3)))
constexpr int BM = 256, BK = 64, HALF = 128, HTB = HALF * BK * 2  , STAGE_BYTES = 8 * HTB, NXCD = 8, WGM = 8;

__host__ __device__ __forceinline__ int lds_byte(int r, int c) { const int st = (r >> 4) * 2 + (c >> 5), rr = r & 15, cc = c & 31, ob = rr * 64 + cc * 2; return st * 1024 + (ob ^ (((ob >> 9) & 1) << 5)); }
__host__ __device__ __forceinline__ void stage_rc(int b, int& R, int& C) { const int st = b / 1024, sb = b % 1024, swz = sb ^ (((sb >> 9) & 1) << 5); R = (st >> 1) * 16 + swz / 64; C = (st & 1) * 32 + (swz % 64) / 2; }
__host__ __device__ __forceinline__ int perm32(int rho) { const int n = rho >> 4, i = rho & 15; return 8 * (i >> 2) + 4 * n + (i & 3); }

struct Unit { int pm, pn, e, mt; };
struct Gemm { const bf16_t* A; const bf16_t* Bt; int K; size_t bstride; };

__host__ __device__ __forceinline__ int xcd_remap(int wgid, int nwg) { const int q = nwg / NXCD, r = nwg % NXCD, xcd = wgid % NXCD, off = wgid / NXCD; return (xcd < r ? xcd * (q + 1) : r * (q + 1) + (xcd - r) * q) + off; }

struct StaticOrder {
    int nM, nN, nwg, G, c;
    __device__ void init(int M, int N, int G_, int c_) { nM = M / BM; nN = N / BM; nwg = nM * nN; G = G_; c = c_; }
    __device__ bool next(int i, Unit& u) const {
        const long L = (long)i * G + c; if (L >= nwg) return false;
        const int wgid = xcd_remap((int)L, nwg);
        const int nig = WGM * nN, gid = wgid / nig, fm = gid * WGM, gsz = (nM - fm) < WGM ? (nM - fm) : WGM;
        u.pm = fm + ((wgid % nig) % gsz); u.pn = (wgid % nig) / gsz; u.e = 0; u.mt = 0; return true;
    }
    __device__ __forceinline__ int row(const Unit& u, int r) const { return u.pm * BM + r; }
};
struct GroupedOrder {
    const PG8_LAS int* tb; const PG8_LAS int* cnt; const int* list; int nN, nwg, G, c;
    __device__ void init(const PG8_LAS int* tb_, const PG8_LAS int* cnt_, const int* list_, int nN_, int G_, int c_) { tb = tb_; cnt = cnt_; list = list_; nN = nN_; nwg = tb_[32] * nN_; G = G_; c = c_; }
    __device__ bool next(int i, Unit& u) const {
        const long L = (long)i * G + c; if (L >= nwg) return false;
        const int wgid = xcd_remap((int)L, nwg);
        const int t = wgid / nN; int e = 0; while (t >= tb[e + 1]) ++e;
        u.pm = t; u.pn = wgid % nN; u.e = e; u.mt = t - tb[e]; return true;
    }
    __device__ __forceinline__ int row(const Unit& u, int r) const { const int pos = u.mt * BM + r; return pos < cnt[u.e] ? list[u.e * NTOK + pos] : 0; }
};

__device__ __forceinline__ unsigned cvt_pk_bf16(float lo, float hi) { unsigned r; asm volatile("v_cvt_pk_bf16_f32 %0, %1, %2" : "=v"(r) : "v"(lo), "v"(hi)); return r; }

struct EpiProj {
    static constexpr bool PERM = true;
    bf16_t* O; const float* bias; const float* ropec; const float* ropes;
    __device__ __forceinline__ void operator()(const f32x4 (&acc)[2][2][4][2], const Unit& u, int wr, int wc, int fr, int fq) const {
        const int row0 = u.pm * BM + wr * 64 + fr, colb = u.pn * BM + wc * 32 + 8 * fq, f0 = ((wc * 32 + 8 * fq) & 63) >> 1;
        f32x4 bv[2][2];
#pragma unroll
        for (int bj = 0; bj < 2; ++bj)
#pragma unroll
            for (int n = 0; n < 2; ++n) bv[bj][n] = *(const f32x4*)(bias + colb + bj * HALF + 4 * n);
#pragma unroll
        for (int ai = 0; ai < 2; ++ai)
#pragma unroll
            for (int m = 0; m < 4; ++m) { const int row = row0 + ai * HALF + m * 16;
                const f32x4 cs = *(const f32x4*)(ropec + (size_t)row * 32 + f0), sn = *(const f32x4*)(ropes + (size_t)row * 32 + f0);
                bf16_t* rowp = O + (size_t)row * NPROJ + colb;
#pragma unroll
                for (int bj = 0; bj < 2; ++bj) { const int hidx = u.pn * 2 + bj;
                    f32x4 v0 = acc[ai][bj][m][0] + bv[bj][0], v1 = acc[ai][bj][m][1] + bv[bj][1];
                    if (hidx < PC_ROPE_END / HALF) {
                        f32x4 w0, w1;
                        w0[0] = v0[0] * cs[0] - v0[1] * sn[0]; w0[1] = v0[1] * cs[0] + v0[0] * sn[0]; w0[2] = v0[2] * cs[1] - v0[3] * sn[1]; w0[3] = v0[3] * cs[1] + v0[2] * sn[1];
                        w1[0] = v1[0] * cs[2] - v1[1] * sn[2]; w1[1] = v1[1] * cs[2] + v1[0] * sn[2]; w1[2] = v1[2] * cs[3] - v1[3] * sn[3]; w1[3] = v1[3] * cs[3] + v1[2] * sn[3];
                        const float sc = (hidx < PC_KA / HALF || (hidx >= PC_QD / HALF && hidx < PC_KD / HALF)) ? C2 : 1.0f;
                        v0 = w0 * sc; v1 = w1 * sc; }
                    u32x4 w; w.x = cvt_pk_bf16(v0[0], v0[1]); w.y = cvt_pk_bf16(v0[2], v0[3]); w.z = cvt_pk_bf16(v1[0], v1[1]); w.w = cvt_pk_bf16(v1[2], v1[3]);
                    *(u32x4*)(rowp + bj * HALF) = w; } }
    }
};
struct EpiX1 {
    static constexpr bool PERM = false;
    const float* x; const float* mod; const float* bias; float* out;
    __device__ __forceinline__ void operator()(const f32x4 (&acc)[2][2][4][2], const Unit& u, int wr, int wc, int fr, int fq) const {
        const int row0 = u.pm * BM + wr * 64 + fr, col0 = u.pn * BM + wc * 32 + 4 * fq; const float* gt = mod + ((u.pm * BM) / SEQ) * (NMOD * DM) + 2 * DM;
#pragma unroll
        for (int bj = 0; bj < 2; ++bj)
#pragma unroll
            for (int n = 0; n < 2; ++n) { const int c = col0 + bj * HALF + n * 16; const f32x4 bv = *(const f32x4*)(bias + c), gv = *(const f32x4*)(gt + c);
#pragma unroll
                for (int ai = 0; ai < 2; ++ai)
#pragma unroll
                    for (int m = 0; m < 4; ++m) { const size_t off = (size_t)(row0 + ai * HALF + m * 16) * DM + c;
                        *(f32x4*)(out + off) = *(const f32x4*)(x + off) + gv * (acc[ai][bj][m][n] + bv); } }
    }
};
__device__ __forceinline__ float swiglu1(float g, float l) { g = fminf(g, 7.0f); l = fminf(fmaxf(l, -7.0f), 7.0f); return g * __builtin_amdgcn_rcpf(1.0f + __builtin_amdgcn_exp2f(-1.702f * LOG2E * g)) * (l + 1.0f); }
struct EpiSwiglu {
    static constexpr bool PERM = true;
    const float* b1; bf16_t* act;
    __device__ __forceinline__ void operator()(const f32x4 (&acc)[2][2][4][2], const Unit& u, int wr, int wc, int fr, int fq) const {
        const int row0 = u.pm * BM + wr * 64 + fr, colb = u.pn * BM + wc * 32 + 8 * fq; const float* bias = b1 + (size_t)u.e * (2 * DFF);
        f32x4 bv[2][2];
#pragma unroll
        for (int bj = 0; bj < 2; ++bj)
#pragma unroll
            for (int n = 0; n < 2; ++n) bv[bj][n] = *(const f32x4*)(bias + colb + bj * HALF + 4 * n);
#pragma unroll
        for (int ai = 0; ai < 2; ++ai)
#pragma unroll
            for (int m = 0; m < 4; ++m) { bf16_t* rowp = act + (size_t)(row0 + ai * HALF + m * 16) * DFF + (colb >> 1);
#pragma unroll
                for (int bj = 0; bj < 2; ++bj) { const f32x4 v0 = acc[ai][bj][m][0] + bv[bj][0], v1 = acc[ai][bj][m][1] + bv[bj][1];
                    u32x2 w; w.x = cvt_pk_bf16(swiglu1(v0[0], v0[1]), swiglu1(v0[2], v0[3])); w.y = cvt_pk_bf16(swiglu1(v1[0], v1[1]), swiglu1(v1[2], v1[3]));
                    *(u32x2*)(rowp + bj * (HALF / 2)) = w; } }
    }
};
struct EpiY {
    static constexpr bool PERM = true;
    const float* b2; bf16_t* y;
    __device__ __forceinline__ void operator()(const f32x4 (&acc)[2][2][4][2], const Unit& u, int wr, int wc, int fr, int fq) const {
        const int row0 = u.pm * BM + wr * 64 + fr, colb = u.pn * BM + wc * 32 + 8 * fq; const float* bias = b2 + (size_t)u.e * DM;
        f32x4 bv[2][2];
#pragma unroll
        for (int bj = 0; bj < 2; ++bj)
#pragma unroll
            for (int n = 0; n < 2; ++n) bv[bj][n] = *(const f32x4*)(bias + colb + bj * HALF + 4 * n);
#pragma unroll
        for (int ai = 0; ai < 2; ++ai)
#pragma unroll
            for (int m = 0; m < 4; ++m) { bf16_t* rowp = y + (size_t)(row0 + ai * HALF + m * 16) * DM + colb;
#pragma unroll
                for (int bj = 0; bj < 2; ++bj) { const f32x4 v0 = acc[ai][bj][m][0] + bv[bj][0], v1 = acc[ai][bj][m][1] + bv[bj][1];
                    u32x4 w; w.x = cvt_pk_bf16(v0[0], v0[1]); w.y = cvt_pk_bf16(v0[2], v0[3]); w.z = cvt_pk_bf16(v1[0], v1[1]); w.w = cvt_pk_bf16(v1[2], v1[3]);
                    *(u32x4*)(rowp + bj * HALF) = w; } }
    }
};

template <class Epi, class Sched, bool GATHER>
__device__ __forceinline__ void gemm_phase(PG8_LAS unsigned char* lds, const Gemm g, const Sched& S, const Epi& E) {
    const int tid = threadIdx.x, wid = __builtin_amdgcn_readfirstlane(tid >> 6), lane = tid & 63, wr = wid >> 2, wc = wid & 3, fr = lane & 15, fq = lane >> 4;
    const int K = g.K, nt = K / BK;
    unsigned voffA[2], voffB[2]; int RA[2], CA[2];
#pragma unroll
    for (int i = 0; i < 2; ++i) { int R, C; stage_rc(tid * 16 + i * 8192, R, C); const int Rb = Epi::PERM ? ((R & ~31) + perm32(R & 31)) : R;
        voffA[i] = (unsigned)(R * K + C) * 2u; voffB[i] = (unsigned)(Rb * K + C) * 2u; RA[i] = R; CA[i] = C; }
    const size_t kstep = (size_t)(BK * 2);
    const size_t hstep = (size_t)HALF * K * 2;
    const size_t tstep = 2 * hstep;
    const unsigned ldsw = (unsigned)wid * 1024u;
    const int aoff = lds_byte(wr * 64 + fr, fq * 8), boff = lds_byte(wc * 32 + fr, fq * 8);
    const char* gA = (const char*)g.A;
#define PG8_SA(b, h) (((b) * 2 + (h)) * HTB)
#define PG8_SB(b, h) ((4 + (b) * 2 + (h)) * HTB)
#define PG8_STAGE(bufoff, gbase, voff) do { _Pragma("unroll") for (int _i = 0; _i < 2; ++_i) \
        __builtin_amdgcn_global_load_lds((const unsigned*)((const char*)(gbase) + (voff)[_i]), (PG8_LAS unsigned*)(lds + (bufoff) + ldsw + _i * 8192), 16, 0, 0); } while (0)
#define PG8_STAGE_A(bufoff, dptr, kb, go) do { _Pragma("unroll") for (int _i = 0; _i < 2; ++_i) { \
        const char* _s = GATHER ? (gA + (kb) + (go)[_i]) : ((const char*)(dptr) + voffA[_i]); \
        __builtin_amdgcn_global_load_lds((const unsigned*)_s, (PG8_LAS unsigned*)(lds + (bufoff) + ldsw + _i * 8192), 16, 0, 0); } } while (0)
#define PG8_LDA(dst, b, h) do { _Pragma("unroll") for (int m = 0; m < 4; ++m) _Pragma("unroll") for (int k = 0; k < 2; ++k) dst[m][k] = *(const PG8_LAS bf16x8*)(lds + PG8_SA(b, h) + aoff + m * 2048 + k * 1024); } while (0)
#define PG8_LDB(dst, b, h) do { _Pragma("unroll") for (int n = 0; n < 2; ++n) _Pragma("unroll") for (int k = 0; k < 2; ++k) dst[n][k] = *(const PG8_LAS bf16x8*)(lds + PG8_SB(b, h) + boff + n * 2048 + k * 1024); } while (0)
#define PG8_MMA(ai, bj, At, Bt) do { __builtin_amdgcn_s_setprio(1); _Pragma("unroll") for (int m = 0; m < 4; ++m) _Pragma("unroll") for (int n = 0; n < 2; ++n) _Pragma("unroll") for (int k = 0; k < 2; ++k) \
        acc[ai][bj][m][n] = __builtin_amdgcn_mfma_f32_16x16x32_bf16(Bt[n][k], At[m][k], acc[ai][bj][m][n], 0, 0, 0); __builtin_amdgcn_s_setprio(0); } while (0)
#define PG8_WAIT_V(n) asm volatile("s_waitcnt vmcnt(" #n ")" ::: "memory")
#define PG8_WAIT_L(n) asm volatile("s_waitcnt lgkmcnt(" #n ")" ::: "memory")
#define PG8_BAR __builtin_amdgcn_s_barrier()
#define PG8_SCHED __builtin_amdgcn_sched_barrier(0)
#define PG8_GOFFS(dst, un) do { if (GATHER) { _Pragma("unroll") for (int _h = 0; _h < 2; ++_h) _Pragma("unroll") for (int _i = 0; _i < 2; ++_i) \
        dst[_h][_i] = (unsigned)S.row(un, _h * HALF + RA[_i]) * (unsigned)(K * 2) + (unsigned)(CA[_i] * 2); } } while (0)
    Unit cur, nxt; int ui = 0;
    if (!S.next(0, cur)) return;
    f32x4 acc[2][2][4][2];
#pragma unroll
    for (int a = 0; a < 2; ++a)
#pragma unroll
        for (int b = 0; b < 2; ++b)
#pragma unroll
            for (int m = 0; m < 4; ++m)
#pragma unroll
                for (int n = 0; n < 2; ++n) acc[a][b][m][n] = (f32x4){0.f, 0.f, 0.f, 0.f};
    bf16x8 At[4][2], B0[2][2], B1[2][2];
    unsigned gcur[2][2] = {{0u, 0u}, {0u, 0u}}, gnxt[2][2] = {{0u, 0u}, {0u, 0u}};
    PG8_GOFFS(gcur, cur);
    const char* cA = gA + (GATHER ? (size_t)0 : (size_t)cur.pm * tstep); const char* cB = (const char*)g.Bt + ((size_t)cur.e * g.bstride) * 2 + (size_t)cur.pn * tstep;
    PG8_STAGE(PG8_SB(0, 0), cB, voffB); PG8_STAGE(PG8_SB(0, 1), cB + hstep, voffB); PG8_STAGE_A(PG8_SA(0, 0), cA, (size_t)0, gcur[0]); PG8_STAGE_A(PG8_SA(0, 1), cA + hstep, (size_t)0, gcur[1]);
    if (wr == 1) PG8_BAR;
    PG8_WAIT_V(2); PG8_BAR;
    PG8_STAGE(PG8_SB(1, 0), cB + kstep, voffB); PG8_STAGE_A(PG8_SA(1, 0), cA + kstep, kstep, gcur[0]); PG8_STAGE(PG8_SB(1, 1), cB + hstep + kstep, voffB);
    PG8_WAIT_V(6); PG8_BAR;
    for (;;) {
        const bool has_next = S.next(ui + 1, nxt);
        if (has_next) PG8_GOFFS(gnxt, nxt);
        const char* nA = (has_next && !GATHER) ? gA + (size_t)nxt.pm * tstep : cA; const char* nB = has_next ? (const char*)g.Bt + ((size_t)nxt.e * g.bstride) * 2 + (size_t)nxt.pn * tstep : cB;
        for (int t = 0; t < nt; t += 2) {
            const bool last = (t == nt - 2);
            const char* a1 = cA + (size_t)(t + 1) * kstep;
            const char* a2 = last ? nA : cA + (size_t)(t + 2) * kstep; const char* b2 = last ? nB : cB + (size_t)(t + 2) * kstep;
            const char* a3 = a2 + kstep; const char* b3 = b2 + kstep;
            const size_t k1 = (size_t)(t + 1) * kstep, k2 = last ? (size_t)0 : (size_t)(t + 2) * kstep, k3 = k2 + kstep;
            unsigned gsel[2][2];
#pragma unroll
            for (int h = 0; h < 2; ++h)
#pragma unroll
                for (int i = 0; i < 2; ++i) gsel[h][i] = (last && has_next) ? gnxt[h][i] : gcur[h][i];
            PG8_LDB(B0, 0, 0); PG8_LDB(B1, 0, 1); PG8_SCHED; PG8_LDA(At, 0, 0); PG8_STAGE_A(PG8_SA(1, 1), a1 + hstep, k1, gcur[1]);
            PG8_WAIT_V(8); PG8_WAIT_L(0); PG8_BAR; PG8_MMA(0, 0, At, B0); PG8_MMA(0, 1, At, B1); PG8_BAR; PG8_SCHED;
            PG8_LDA(At, 0, 1); PG8_STAGE(PG8_SB(0, 0), b2, voffB); PG8_STAGE(PG8_SB(0, 1), b2 + hstep, voffB); PG8_STAGE_A(PG8_SA(0, 0), a2, k2, gsel[0]);
            PG8_WAIT_V(8); PG8_WAIT_L(0); PG8_BAR; PG8_MMA(1, 0, At, B0); PG8_MMA(1, 1, At, B1); PG8_BAR; PG8_SCHED;
            PG8_LDB(B0, 1, 0); PG8_LDB(B1, 1, 1); PG8_SCHED; PG8_LDA(At, 1, 0); PG8_STAGE_A(PG8_SA(0, 1), a2 + hstep, k2, gsel[1]);
            PG8_WAIT_V(8); PG8_WAIT_L(0); PG8_BAR; PG8_MMA(0, 0, At, B0); PG8_MMA(0, 1, At, B1); PG8_BAR; PG8_SCHED;
            PG8_LDA(At, 1, 1); PG8_STAGE(PG8_SB(1, 0), b3, voffB); PG8_STAGE(PG8_SB(1, 1), b3 + hstep, voffB); PG8_STAGE_A(PG8_SA(1, 0), a3, k3, gsel[0]);
            PG8_WAIT_V(8); PG8_WAIT_L(0); PG8_BAR; PG8_MMA(1, 0, At, B0); PG8_MMA(1, 1, At, B1); PG8_BAR; PG8_SCHED;
        }
        if (wr == 0) PG8_BAR;
        E(acc, cur, wr, wc, fr, fq);
        if (!has_next) break;
#pragma unroll
        for (int a = 0; a < 2; ++a)
#pragma unroll
            for (int b = 0; b < 2; ++b)
#pragma unroll
                for (int m = 0; m < 4; ++m)
#pragma unroll
                    for (int n = 0; n < 2; ++n) acc[a][b][m][n] = (f32x4){0.f, 0.f, 0.f, 0.f};
        cur = nxt; cA = nA; cB = nB; ++ui;
#pragma unroll
        for (int h = 0; h < 2; ++h)
#pragma unroll
            for (int i = 0; i < 2; ++i) gcur[h][i] = gnxt[h][i];
        if (wr == 1) PG8_BAR;
    }
    PG8_WAIT_V(0);
    PG8_BAR;
#undef PG8_SA
#undef PG8_SB
#undef PG8_STAGE
#undef PG8_STAGE_A
#undef PG8_LDA
#undef PG8_LDB
#undef PG8_MMA
#undef PG8_WAIT_V
#undef PG8_WAIT_L
#undef PG8_BAR
#undef PG8_SCHED
#undef PG8_GOFFS
}
}
namespace attn_body {
using bf16=unsigned short;
using bf16x8=__attribute__((ext_vector_type(8)))short;
using s16x4=__attribute__((ext_vector_type(4)))short;
using f32x16=::f32x16;
using u32x4=__attribute__((ext_vector_type(4)))unsigned;
constexpr int D=64,DM=2304;
constexpr int NW=8,QBLK=32,QB=QBLK*NW,KVBLK=64;
__device__ __forceinline__ int crow(int r,int hi){return (r&3)+8*(r>>2)+4*hi;}
#define SBAR() __builtin_amdgcn_sched_barrier(0)
__device__ __forceinline__ void cmask(f32x16&p0,f32x16&p1,int jb,int qrel,int hi){
  const float NEG=-INFINITY; int kb=64*jb+4*hi;
  #pragma unroll
  for(int r=0;r<16;++r){int kv=kb+(r&3)+8*(r>>2); if(kv>qrel)p0[r]=NEG; if(kv+32>qrel)p1[r]=NEG;}
}

__device__ __forceinline__ void smask(f32x16&p0,f32x16&p1,int t,int qrel,int hi,int shift){
  const float NEG=-INFINITY; int kb=64*t-shift+4*hi;
  #pragma unroll
  for(int r=0;r<16;++r){int kv=kb+(r&3)+8*(r>>2); if(kv>qrel||kv<=qrel-128)p0[r]=NEG; if(kv+32>qrel||kv+32<=qrel-128)p1[r]=NEG;}
}
constexpr int NSLOT=3, SLOTB=8192;
constexpr int LDS_K=0, LDS_V=NSLOT*SLOTB, LDS_WS=2*NSLOT*SLOTB, LDS_OST=LDS_WS+NW*64*4, LDS_BYTES=LDS_OST+NW*4096;
__device__ __forceinline__ void glds16(const void*gsrc,unsigned lds_dst){unsigned keep;
  asm volatile("s_mov_b32 %0, m0\n\ts_mov_b32 m0, %2\n\ts_nop 0\n\tglobal_load_lds_dwordx4 %1, off\n\ts_mov_b32 m0, %0":"=&s"(keep):"v"(gsrc),"s"(lds_dst):"memory");}
__device__ __forceinline__ float max3f(float a,float b,float c){float r;asm("v_max3_f32 %0, %1, %2, %3":"=v"(r):"v"(a),"v"(b),"v"(c));return r;}
__device__ __forceinline__ float max2f(float a,float b){float r;asm("v_max_f32_e32 %0, %1, %2":"=v"(r):"v"(a),"v"(b));return r;}
__device__ __forceinline__ float fadd_s(float a,float b){float r;asm("v_add_f32_e32 %0, %1, %2":"=v"(r):"v"(a),"v"(b));return r;}
__device__ __forceinline__ float fsub_s(float a,float b){float r;asm("v_sub_f32_e32 %0, %1, %2":"=v"(r):"v"(a),"v"(b));return r;}
typedef float f32x2_t __attribute__((ext_vector_type(2))); typedef __bf16 bf16x2_t __attribute__((ext_vector_type(2)));
__device__ __forceinline__ unsigned cvtpk_s(float lo,float hi){f32x2_t v={lo,hi};bf16x2_t b=__builtin_convertvector(v,bf16x2_t);return __builtin_bit_cast(unsigned,b);}
#define WAIT_BAR(N) asm volatile("s_waitcnt vmcnt(" #N ") lgkmcnt(0)\n\ts_barrier":::"memory")

__device__ __forceinline__ void qkt(f32x16&p0,f32x16&p1,const char*Kslot,const bf16x8*qr,const f32x16&negm,int r32,int hi){
  const char*kb=Kslot+hi*1024+r32*16;
  #pragma unroll
  for(int d0=0;d0<4;++d0){
    const bf16x8 b0=*reinterpret_cast<const bf16x8*>(kb+d0*2048);
    const bf16x8 b1=*reinterpret_cast<const bf16x8*>(kb+d0*2048+512);
    if(d0==0){p0=__builtin_amdgcn_mfma_f32_32x32x16_bf16(b0,qr[0],negm,0,0,0);p1=__builtin_amdgcn_mfma_f32_32x32x16_bf16(b1,qr[0],negm,0,0,0);}
    else{p0=__builtin_amdgcn_mfma_f32_32x32x16_bf16(b0,qr[d0],p0,0,0,0);p1=__builtin_amdgcn_mfma_f32_32x32x16_bf16(b1,qr[d0],p1,0,0,0);}}
}
typedef __attribute__((address_space(3))) const char* lds_cptr;
typedef short v4i16_t __attribute__((ext_vector_type(4)));
__device__ __forceinline__ void kload8(bf16x8*kf,lds_cptr kp){
  kf[0]=*(const __attribute__((address_space(3))) bf16x8*)(kp);      kf[1]=*(const __attribute__((address_space(3))) bf16x8*)(kp+512);
  kf[2]=*(const __attribute__((address_space(3))) bf16x8*)(kp+2048); kf[3]=*(const __attribute__((address_space(3))) bf16x8*)(kp+2560);
  kf[4]=*(const __attribute__((address_space(3))) bf16x8*)(kp+4096); kf[5]=*(const __attribute__((address_space(3))) bf16x8*)(kp+4608);
  kf[6]=*(const __attribute__((address_space(3))) bf16x8*)(kp+6144); kf[7]=*(const __attribute__((address_space(3))) bf16x8*)(kp+6656);
}
__device__ __forceinline__ void kload2(bf16x8*kf,lds_cptr kp,int j){ kf[2*j]=*(const __attribute__((address_space(3))) bf16x8*)(kp+j*2048); kf[2*j+1]=*(const __attribute__((address_space(3))) bf16x8*)(kp+j*2048+512); }
__device__ __forceinline__ s16x4 vtr(lds_cptr p){ return __builtin_bit_cast(s16x4,__builtin_amdgcn_ds_read_tr16_b64_v4i16((__attribute__((address_space(3))) v4i16_t*)p)); }
__device__ __forceinline__ float rowmax(const f32x16&p0,const f32x16&p1){
  float a=max3f(p0[0],p0[1],p1[0]),b=max3f(p0[2],p0[3],p1[1]);a=max3f(a,p1[2],p1[3]);
  #pragma unroll
  for(int r=4;r<16;r+=4){a=max3f(a,p0[r],p0[r+1]);b=max3f(b,p0[r+2],p0[r+3]);a=max3f(a,p1[r],p1[r+1]);b=max3f(b,p1[r+2],p1[r+3]);}
  const float m=max2f(a,b);
  auto rr=__builtin_amdgcn_permlane32_swap(__float_as_uint(m),__float_as_uint(m),false,false);
  return max2f(__uint_as_float(rr[0]),__uint_as_float(rr[1]));
}
__device__ __forceinline__ void pv(f32x16*o,int vb,bf16x8 pa0,bf16x8 pa1,bf16x8 pa2,bf16x8 pa3){
  #pragma unroll
  for(int d0=0;d0<2;++d0){s16x4 lo[4],hi[4];
    #pragma unroll
    for(int ks=0;ks<4;++ks){
      asm volatile("ds_read_b64_tr_b16 %0,%1 offset:%c2":"=&v"(lo[ks]):"v"(vb),"i"(d0*4096+ks*1024):"memory");
      asm volatile("ds_read_b64_tr_b16 %0,%1 offset:%c2":"=&v"(hi[ks]):"v"(vb),"i"(d0*4096+ks*1024+512):"memory");}
    asm volatile("s_waitcnt lgkmcnt(0)":::"memory");SBAR();
    #define PK(k) (bf16x8){lo[k][0],lo[k][1],lo[k][2],lo[k][3],hi[k][0],hi[k][1],hi[k][2],hi[k][3]}
    o[d0]=__builtin_amdgcn_mfma_f32_32x32x16_bf16(pa0,PK(0),o[d0],0,0,0);
    o[d0]=__builtin_amdgcn_mfma_f32_32x32x16_bf16(pa1,PK(1),o[d0],0,0,0);
    o[d0]=__builtin_amdgcn_mfma_f32_32x32x16_bf16(pa2,PK(2),o[d0],0,0,0);
    o[d0]=__builtin_amdgcn_mfma_f32_32x32x16_bf16(pa3,PK(3),o[d0],0,0,0);
    #undef PK
  }
}

#ifndef ATTN_STORE16
#define ATTN_STORE16(p,v) (*(u32x4*)(p)=(v))
#endif
template<int THRL,int MODE> __device__ __forceinline__ void attn_unit(const bf16*Qu,const bf16*__restrict__ Kh,const bf16*__restrict__ Vh,bf16*Ou,const int opitch,const int NT,const int shift,const float sink2,char*shm){
  int tid_=threadIdx.x; asm volatile("":"+v"(tid_));
  const int tid=tid_,lane=tid&63,r32=lane&31,hi=lane>>5; const int wid=__builtin_amdgcn_readfirstlane(tid>>6);
  const bf16*Qw=Qu+(long)(wid*QBLK)*DM;
  const unsigned lds0=(unsigned)(uintptr_t)shm;
  float*wsf=(float*)(shm+LDS_WS)+wid*64;
  const bf16*ksrc=Kh+(long)lane*DM+wid*8;
  const bf16*vsrc=Vh+(long)(16*(wid&3)+(lane>>2))*DM+(wid>>2)*32+(lane&3)*8;
  const unsigned kdst=lds0+LDS_K+wid*1024, vdst=lds0+LDS_V+wid*1024;
  #define DMA_K(t,slot) glds16(ksrc+(long)(t)*KVBLK*DM,(unsigned)__builtin_amdgcn_readfirstlane(kdst+(slot)))
  #define DMA_V(t,slot) glds16(vsrc+(long)(t)*KVBLK*DM,(unsigned)__builtin_amdgcn_readfirstlane(vdst+(slot)))
  const int vb0=(int)(lds0+LDS_V)+((lane>>4)&1)*32+(lane&3)*8+(4*hi+((lane&15)>>2))*64;
  const char*Kbase=shm+LDS_K; bf16x8 kf[8];
  const lds_cptr shm3=(lds_cptr)shm; const lds_cptr kp0=shm3+LDS_K+hi*1024+r32*16; const lds_cptr vp0=shm3+LDS_V+((lane>>4)&1)*32+(lane&3)*8+(4*hi+((lane&15)>>2))*64;
  DMA_K(0,0);DMA_V(0,0);DMA_K(1,SLOTB);
  bf16x8 qr[4];
  #pragma unroll
  for(int d0=0;d0<4;++d0)qr[d0]=*reinterpret_cast<const bf16x8*>(&Qw[(long)r32*DM+d0*16+hi*8]);
  float mhat=0.f,l_reg=0.f;f32x16 o[2];o[0]=f32x16{};o[1]=f32x16{};f32x16 negm=f32x16{};
  if(MODE==1){ mhat=sink2; l_reg=hi?0.f:1.f; _Pragma("unroll") for(int r=0;r<16;++r)negm[r]=-sink2; }
  asm volatile("":"+v"(negm));
  const int qrel=wid*QBLK+r32;
  #define CMASK(P0,P1,t) do{ if(MODE==0){int jb_=(t)-(NT-4); if(jb_>=0)cmask(P0,P1,jb_,qrel,hi);} else smask(P0,P1,(t),qrel,hi,shift); }while(0)
  bool resc=false;
  #define START(P0,P1) do{ const float rm=rowmax(P0,P1); resc=false; \
    if(MODE==0 || __any(rm>(float)THRL)){ const float dl=(MODE==0)?rm:__builtin_fmaxf(rm,0.f); if(MODE==1)l_reg*=__builtin_amdgcn_exp2f(-dl); mhat=fadd_s(mhat,dl); \
      _Pragma("unroll") for(int r=0;r<16;++r){P0[r]=fsub_s(P0[r],dl);P1[r]=fsub_s(P1[r],dl);} \
      _Pragma("unroll") for(int r=0;r<16;++r)negm[r]=-mhat; asm volatile("":"+v"(negm)); } \
    _Pragma("unroll") for(int r=0;r<16;++r)P0[r]=__builtin_amdgcn_exp2f(P0[r]); }while(0)
  #define RESC() do{ if(resc){ asm volatile("s_waitcnt lgkmcnt(0)":::"memory"); \
      _Pragma("unroll") for(int d_=0;d_<2;++d_) _Pragma("unroll") for(int r=0;r<16;++r)o[d_][r]*=wsf[crow(r,hi)]; } }while(0)
  f32x16 pA0,pA1,pB0,pB1;
  int sl_prev=0,sl_cur=0,sl_next=SLOTB;
  #define ROT() do{sl_prev=sl_cur;sl_cur=sl_next;sl_next=(sl_next==(NSLOT-1)*SLOTB)?0:sl_next+SLOTB;}while(0)
  DMA_K(2,2*SLOTB);
  WAIT_BAR(3);
  qkt(pA0,pA1,Kbase,qr,negm,r32,hi);asm volatile("s_nop 15\n\ts_nop 7":"+v"(pA0),"+v"(pA1));CMASK(pA0,pA1,0);
  START(pA0,pA1);
  _Pragma("unroll") for(int r=0;r<16;++r)pA1[r]=__builtin_amdgcn_exp2f(pA1[r]);
  WAIT_BAR(0);
  DMA_K(3,0);DMA_V(1,SLOTB);
  ROT();
  kload8(kf,kp0+sl_cur);
  WAIT_BAR(2);
  s16x4 vlo[8],vhi[8]; u32x4 pw0,pw1,pw2,pw3;
  #define PKW(P,B) cvtpk_s(P[B],P[B+1])
  #define PAF(k) __builtin_bit_cast(bf16x8,pw##k)
  #define VFR(i) (bf16x8){vlo[i][0],vlo[i][1],vlo[i][2],vlo[i][3],vhi[i][0],vhi[i][1],vhi[i][2],vhi[i][3]}
  #define PIN(x) asm volatile("":"+v"(x))
  #define MX3(a,b,c) __builtin_fmaxf(__builtin_fmaxf((a),(b)),(c))
  #define GAPA(MF,A0,A1,A2,A3,W0,W1,PW) do{ MF; sacc+=A0; sacc+=A1; sacc+=A2; sacc+=A3; PIN(sacc); W0; W1; PIN(PW); SBAR(); }while(0)
  #define EX(v) __builtin_amdgcn_exp2f(v)
  #define GAPB(MF,X,B) do{ MF; X[B]=EX(X[B]); X[B+1]=EX(X[B+1]); X[B+2]=EX(X[B+2]); X[B+3]=EX(X[B+3]); PIN(X); SBAR(); }while(0)
  #define VRD(i) do{ vlo[i]=vtr(vp_+(((i)>>2)*4096+((i)&3)*1024)); vhi[i]=vtr(vp_+(((i)>>2)*4096+((i)&3)*1024+512)); }while(0)
  #define KRD(G,j) do{ if(G){ kload2(kf,kp0+sl_next,j); SBAR(); } }while(0)
  #define STEP(C0,C1,P0,P1,t,GK,GV,GL) do{ SBAR(); \
    const lds_cptr vp_=vp0+sl_prev; \
    VRD(0); SBAR(); float sacc=(P0[0]+P0[1]); \
    GAPA(C0=__builtin_amdgcn_mfma_f32_32x32x16_bf16(kf[0],qr[0],negm,0,0,0), P0[2],P0[3],P0[4],P0[5],     pw0[0]=PKW(P0,0), pw0[1]=PKW(P0,2), pw0); \
    VRD(4); SBAR(); GAPA(C1=__builtin_amdgcn_mfma_f32_32x32x16_bf16(kf[1],qr[0],negm,0,0,0), P0[6],P0[7],P0[8],P0[9],     pw0[2]=PKW(P0,4), pw0[3]=PKW(P0,6), pw0); \
    VRD(1); SBAR(); GAPA(C0=__builtin_amdgcn_mfma_f32_32x32x16_bf16(kf[2],qr[1],C0,0,0,0),   P0[10],P0[11],P0[12],P0[13], pw1[0]=PKW(P0,8), pw1[1]=PKW(P0,10), pw1); \
    VRD(5); SBAR(); GAPA(C1=__builtin_amdgcn_mfma_f32_32x32x16_bf16(kf[3],qr[1],C1,0,0,0),   P0[14],P0[15],P1[0],P1[1],   pw1[2]=PKW(P0,12),pw1[3]=PKW(P0,14), pw1); \
    VRD(2); SBAR(); GAPA(C0=__builtin_amdgcn_mfma_f32_32x32x16_bf16(kf[4],qr[2],C0,0,0,0),   P1[2],P1[3],P1[4],P1[5],     pw2[0]=PKW(P1,0), pw2[1]=PKW(P1,2), pw2); \
    VRD(6); SBAR(); GAPA(C1=__builtin_amdgcn_mfma_f32_32x32x16_bf16(kf[5],qr[2],C1,0,0,0),   P1[6],P1[7],P1[8],P1[9],     pw2[2]=PKW(P1,4), pw2[3]=PKW(P1,6), pw2); \
    VRD(3); SBAR(); GAPA(C0=__builtin_amdgcn_mfma_f32_32x32x16_bf16(kf[6],qr[3],C0,0,0,0),   P1[10],P1[11],P1[12],P1[13], pw3[0]=PKW(P1,8), pw3[1]=PKW(P1,10), pw3); \
    VRD(7); SBAR(); GAPA(C1=__builtin_amdgcn_mfma_f32_32x32x16_bf16(kf[7],qr[3],C1,0,0,0),   P1[14],P1[15],0.f,0.f,       pw3[2]=PKW(P1,12),pw3[3]=PKW(P1,14), pw3); \
    l_reg+=sacc; \
    if(GK){DMA_K((t)+3,sl_cur);} if(GV){DMA_V((t)+1,sl_next);} \
    CMASK(C0,C1,t); \
    { float a=MX3(C0[0],C0[1],C1[0]),b=MX3(C0[2],C0[3],C1[1]); a=MX3(a,C1[2],C1[3]); \
      _Pragma("unroll") for(int r=4;r<16;r+=4){a=MX3(a,C0[r],C0[r+1]);b=MX3(b,C0[r+2],C0[r+3]);a=MX3(a,C1[r],C1[r+1]);b=MX3(b,C1[r+2],C1[r+3]);} \
      float rm=__builtin_fmaxf(a,b); { auto rr=__builtin_amdgcn_permlane32_swap(__float_as_uint(rm),__float_as_uint(rm),false,false); rm=__builtin_fmaxf(__uint_as_float(rr[0]),__uint_as_float(rr[1])); } \
      resc=false; \
      if(__builtin_expect(__any(rm>(float)THRL),0)){ const float dl=__builtin_fmaxf(rm,0.f); mhat+=dl; \
        _Pragma("unroll") for(int r=0;r<16;++r){C0[r]-=dl;C1[r]-=dl;} \
        _Pragma("unroll") for(int r=0;r<16;++r)negm[r]=-mhat; asm volatile("":"+v"(negm)); \
        const float f=__builtin_amdgcn_exp2f(-dl); l_reg*=f; if(hi==0)wsf[r32]=f; resc=true; } } \
    SBAR(); \
    GAPB(o[0]=__builtin_amdgcn_mfma_f32_32x32x16_bf16(PAF(0),VFR(0),o[0],0,0,0), C0,0); \
    GAPB(o[1]=__builtin_amdgcn_mfma_f32_32x32x16_bf16(PAF(0),VFR(4),o[1],0,0,0), C0,4); \
    KRD(GL,0); GAPB(o[0]=__builtin_amdgcn_mfma_f32_32x32x16_bf16(PAF(1),VFR(1),o[0],0,0,0), C0,8); \
    KRD(GL,1); GAPB(o[1]=__builtin_amdgcn_mfma_f32_32x32x16_bf16(PAF(1),VFR(5),o[1],0,0,0), C0,12); \
    KRD(GL,2); GAPB(o[0]=__builtin_amdgcn_mfma_f32_32x32x16_bf16(PAF(2),VFR(2),o[0],0,0,0), C1,0); \
    KRD(GL,3); GAPB(o[1]=__builtin_amdgcn_mfma_f32_32x32x16_bf16(PAF(2),VFR(6),o[1],0,0,0), C1,4); \
    GAPB(o[0]=__builtin_amdgcn_mfma_f32_32x32x16_bf16(PAF(3),VFR(3),o[0],0,0,0), C1,8); \
    GAPB(o[1]=__builtin_amdgcn_mfma_f32_32x32x16_bf16(PAF(3),VFR(7),o[1],0,0,0), C1,12); \
    }while(0)
  int t=1;
  #undef CMASK
  #define CMASK(P0,P1,t) do{}while(0)
  for(;t+5<NT;t+=2){
    STEP(pB0,pB1,pA0,pA1,t,true,true,true);     WAIT_BAR(2); RESC(); ROT();
    STEP(pA0,pA1,pB0,pB1,t+1,true,true,true);   WAIT_BAR(2); RESC(); ROT();
  }
  #undef CMASK
  #define CMASK(P0,P1,t) do{ if(MODE==0){int jb_=(t)-(NT-4); if(jb_>=0)cmask(P0,P1,jb_,qrel,hi);} else smask(P0,P1,(t),qrel,hi,shift); }while(0)
  #define ENDW(tt) do{ if((tt)+3<NT){WAIT_BAR(2);} else if((tt)+2<NT){WAIT_BAR(1);} else {WAIT_BAR(0);} }while(0)
  for(;t+1<NT;t+=2){
    STEP(pB0,pB1,pA0,pA1,t,(t+3<NT),(t+1<NT),(t+1<NT));       ENDW(t);   RESC(); ROT();
    STEP(pA0,pA1,pB0,pB1,t+1,(t+4<NT),(t+2<NT),(t+2<NT));     ENDW(t+1); RESC(); ROT();
  }
  STEP(pB0,pB1,pA0,pA1,NT-1,false,false,false); RESC();
  { float sacc=pB0[0]+pB0[1]; _Pragma("unroll") for(int r=2;r<16;++r)sacc+=pB0[r]; _Pragma("unroll") for(int r=0;r<16;++r)sacc+=pB1[r]; l_reg+=sacc;
    pw0=(u32x4){PKW(pB0,0),PKW(pB0,2),PKW(pB0,4),PKW(pB0,6)};pw1=(u32x4){PKW(pB0,8),PKW(pB0,10),PKW(pB0,12),PKW(pB0,14)};pw2=(u32x4){PKW(pB1,0),PKW(pB1,2),PKW(pB1,4),PKW(pB1,6)};pw3=(u32x4){PKW(pB1,8),PKW(pB1,10),PKW(pB1,12),PKW(pB1,14)};
    SBAR(); pv(o,vb0+sl_cur,PAF(0),PAF(1),PAF(2),PAF(3)); }
  #undef PKW
  #undef PAF
  #undef VFR
  #undef PIN
  #undef MX3
  #undef GAPA
  #undef GAPB
  #undef EX
  #undef VRD
  #undef KRD
  #undef STEP
  #undef ENDW
  {auto rr=__builtin_amdgcn_permlane32_swap(__float_as_uint(l_reg),__float_as_uint(l_reg),false,false);l_reg=__uint_as_float(rr[0])+__uint_as_float(rr[1]);}
  if(hi==0)wsf[32+r32]=l_reg;asm volatile("s_waitcnt lgkmcnt(0)":::"memory");
  float rli[16];
  #pragma unroll
  for(int r=0;r<16;++r)rli[r]=__builtin_amdgcn_rcpf(wsf[32+crow(r,hi)]);
  bf16*Ow=Ou+(long)(wid*QBLK)*opitch;
  { bf16*stg=(bf16*)(shm+LDS_OST)+wid*2048;
    #pragma unroll
    for(int r=0;r<16;++r){const int orow=crow(r,hi);
      #pragma unroll
      for(int d0=0;d0<2;++d0)stg[orow*64+d0*32+r32]=(bf16)(cvtpk_s(o[d0][r]*rli[r],0.f)&0xffffu);}
    asm volatile("s_waitcnt lgkmcnt(0)":::"memory");
    #pragma unroll
    for(int i=0;i<4;++i){const int row=i*8+(lane>>3),ch=lane&7; const u32x4 v=*(const u32x4*)(stg+row*64+ch*8); ATTN_STORE16(Ow+(long)row*opitch+ch*8,v);} }
  asm volatile("s_waitcnt lgkmcnt(0)\n\ts_barrier":::"memory");
  #undef DMA_K
  #undef DMA_V
  #undef CMASK
  #undef START
  #undef RESC
  #undef ROT
}
constexpr int N_LDS_V=NSLOT*SLOTB, N_LDS_WS=N_LDS_V+NSLOT*2*SLOTB, N_LDS_OST=N_LDS_WS+NW*64*4, N_LDS_BYTES=N_LDS_OST+NW*8192;
template<int THRL> __device__ __forceinline__ void attn_unit128(const bf16*Qu,const bf16*__restrict__ Kh,const bf16*__restrict__ Vh,bf16*Ou,const int opitch,const int NT,char*shm){
  constexpr int MODE=0; const int shift=0;
  int tid_=threadIdx.x; asm volatile("":"+v"(tid_));
  const int tid=tid_,lane=tid&63,r32=lane&31,hi=lane>>5; const int wid=__builtin_amdgcn_readfirstlane(tid>>6);
  const bf16*Qw=Qu+(long)(wid*QBLK)*DM;
  const unsigned lds0=(unsigned)(uintptr_t)shm;
  float*wsf=(float*)(shm+N_LDS_WS)+wid*64;
  const bf16*ksrc=Kh+(long)lane*DM+wid*8;
  const bf16*vsrc=Vh+(long)(16*(wid&3)+(lane>>2))*DM+(wid>>2)*32+(lane&3)*8;
  const unsigned kdst=lds0+LDS_K+wid*1024, vdst=lds0+N_LDS_V+wid*1024;
  #define DMA_K(t,slot) glds16(ksrc+(long)(t)*KVBLK*DM,(unsigned)__builtin_amdgcn_readfirstlane(kdst+(slot)))
  #define DMA_V(t,slot) do{ glds16(vsrc+(long)(t)*KVBLK*DM,(unsigned)__builtin_amdgcn_readfirstlane(vdst+2*(slot))); glds16(vsrc+(long)(t)*KVBLK*DM+64,(unsigned)__builtin_amdgcn_readfirstlane(vdst+2*(slot)+8192)); }while(0)
  const int vb0=(int)(lds0+N_LDS_V)+((lane>>4)&1)*32+(lane&3)*8+(4*hi+((lane&15)>>2))*64;
  const char*Kbase=shm+LDS_K; bf16x8 kf[8];
  const lds_cptr shm3=(lds_cptr)shm; const lds_cptr kp0=shm3+LDS_K+hi*1024+r32*16; const lds_cptr vp0=shm3+N_LDS_V+((lane>>4)&1)*32+(lane&3)*8+(4*hi+((lane&15)>>2))*64;
  DMA_K(0,0);DMA_V(0,0);DMA_K(1,SLOTB);
  typedef __attribute__((address_space(3))) bf16x8* lds_qptr; const lds_qptr qst=(lds_qptr)(shm3+N_LDS_OST+wid*8192)+lane;
  { bf16x8 qr[4];
  #pragma unroll
  for(int d0=0;d0<4;++d0)qr[d0]=*reinterpret_cast<const bf16x8*>(&Qw[(long)r32*DM+d0*16+hi*8]);
  #pragma unroll
  for(int d0=0;d0<4;++d0)qst[64*d0]=qr[d0]; }
  #define QF(d0) (qst[64*(d0)])
  float mhat=0.f,l_reg=0.f;f32x16 o[4],negm; { float z_; asm volatile("v_mov_b32 %0, 0":"=v"(z_));
    _Pragma("unroll") for(int r=0;r<16;++r){o[0][r]=z_;o[1][r]=z_;o[2][r]=z_;o[3][r]=z_;negm[r]=z_;} }
  asm volatile("":"+v"(negm));
  const int qrel=wid*QBLK+r32;
  #define CMASK(P0,P1,t) do{ if(MODE==0){int jb_=(t)-(NT-4); if(jb_>=0)cmask(P0,P1,jb_,qrel,hi);} else smask(P0,P1,(t),qrel,hi,shift); }while(0)
  bool resc=false;
  #define START(P0,P1) do{ const float rm=rowmax(P0,P1); resc=false; \
    if(MODE==0 || __any(rm>(float)THRL)){ const float dl=(MODE==0)?rm:__builtin_fmaxf(rm,0.f); if(MODE==1)l_reg*=__builtin_amdgcn_exp2f(-dl); mhat=fadd_s(mhat,dl); \
      _Pragma("unroll") for(int r=0;r<16;++r){P0[r]=fsub_s(P0[r],dl);P1[r]=fsub_s(P1[r],dl);} \
      _Pragma("unroll") for(int r=0;r<16;++r)negm[r]=-mhat; asm volatile("":"+v"(negm)); } \
    _Pragma("unroll") for(int r=0;r<16;++r)P0[r]=__builtin_amdgcn_exp2f(P0[r]); }while(0)
  #define RESC() do{ if(resc){ asm volatile("s_waitcnt lgkmcnt(0)":::"memory"); \
      _Pragma("unroll") for(int d_=0;d_<4;++d_) _Pragma("unroll") for(int r=0;r<16;++r)o[d_][r]*=wsf[crow(r,hi)]; } }while(0)
  f32x16 pA0,pA1,pB0,pB1;
  int sl_prev=0,sl_cur=0,sl_next=SLOTB;
  #define ROT() do{sl_prev=sl_cur;sl_cur=sl_next;sl_next=(sl_next==(NSLOT-1)*SLOTB)?0:sl_next+SLOTB;}while(0)
  DMA_K(2,2*SLOTB);
  WAIT_BAR(4);
  { bf16x8 qr[4]; _Pragma("unroll") for(int d0=0;d0<4;++d0)qr[d0]=QF(d0); qkt(pA0,pA1,Kbase,qr,negm,r32,hi); }asm volatile("s_nop 15\n\ts_nop 7":"+v"(pA0),"+v"(pA1));CMASK(pA0,pA1,0);
  START(pA0,pA1);
  _Pragma("unroll") for(int r=0;r<16;++r)pA1[r]=__builtin_amdgcn_exp2f(pA1[r]);
  WAIT_BAR(0);
  DMA_K(3,0);DMA_V(1,SLOTB);
  ROT();
  kload8(kf,kp0+sl_cur);
  WAIT_BAR(3);
  s16x4 vlo[8],vhi[8]; u32x4 pw0,pw1,pw2,pw3;
  #define PKW(P,B) cvtpk_s(P[B],P[B+1])
  #define PAF(k) __builtin_bit_cast(bf16x8,pw##k)
  #define VFR(i) (bf16x8){vlo[i][0],vlo[i][1],vlo[i][2],vlo[i][3],vhi[i][0],vhi[i][1],vhi[i][2],vhi[i][3]}
  #define PIN(x) asm volatile("":"+v"(x))
  #define MX3(a,b,c) __builtin_fmaxf(__builtin_fmaxf((a),(b)),(c))
  #define GAPA(MF,A0,A1,A2,A3,W0,W1,PW) do{ MF; sacc+=A0; sacc+=A1; sacc+=A2; sacc+=A3; PIN(sacc); W0; W1; PIN(PW); SBAR(); }while(0)
  #define EX(v) __builtin_amdgcn_exp2f(v)
  #define GAPB(MF,X,B,RD) do{ MF; X[B]=EX(X[B]); X[B+1]=EX(X[B+1]); PIN(X); RD; SBAR(); }while(0)
  #define VRD2(i) do{ vlo[i]=vtr(vp_+((2+((i)>>2))*4096+((i)&3)*1024)); vhi[i]=vtr(vp_+((2+((i)>>2))*4096+((i)&3)*1024+512)); }while(0)
  #define NORD do{}while(0)
  #define VRD(i) do{ vlo[i]=vtr(vp_+(((i)>>2)*4096+((i)&3)*1024)); vhi[i]=vtr(vp_+(((i)>>2)*4096+((i)&3)*1024+512)); }while(0)
  #define KRD(G,j) do{ if(G){ kload2(kf,kp0+sl_next,j); SBAR(); } }while(0)
  #define STEP(C0,C1,P0,P1,t,GK,GV,GL) do{ SBAR(); \
    const lds_cptr vp_=vp0+2*sl_prev; \
    bf16x8 qa_=QF(0),qb_=QF(1); VRD(0); SBAR(); float sacc=(P0[0]+P0[1]); \
    GAPA(C0=__builtin_amdgcn_mfma_f32_32x32x16_bf16(kf[0],qa_,negm,0,0,0), P0[2],P0[3],P0[4],P0[5],     pw0[0]=PKW(P0,0), pw0[1]=PKW(P0,2), pw0); \
    VRD(4); SBAR(); GAPA(C1=__builtin_amdgcn_mfma_f32_32x32x16_bf16(kf[1],qa_,negm,0,0,0), P0[6],P0[7],P0[8],P0[9],     pw0[2]=PKW(P0,4), pw0[3]=PKW(P0,6), pw0); \
    VRD(1); SBAR(); GAPA(C0=__builtin_amdgcn_mfma_f32_32x32x16_bf16(kf[2],qb_,C0,0,0,0),   P0[10],P0[11],P0[12],P0[13], pw1[0]=PKW(P0,8), pw1[1]=PKW(P0,10), pw1); \
    VRD(5); qa_=QF(2); SBAR(); GAPA(C1=__builtin_amdgcn_mfma_f32_32x32x16_bf16(kf[3],qb_,C1,0,0,0),   P0[14],P0[15],P1[0],P1[1],   pw1[2]=PKW(P0,12),pw1[3]=PKW(P0,14), pw1); \
    VRD(2); SBAR(); GAPA(C0=__builtin_amdgcn_mfma_f32_32x32x16_bf16(kf[4],qa_,C0,0,0,0),   P1[2],P1[3],P1[4],P1[5],     pw2[0]=PKW(P1,0), pw2[1]=PKW(P1,2), pw2); \
    VRD(6); qb_=QF(3); SBAR(); GAPA(C1=__builtin_amdgcn_mfma_f32_32x32x16_bf16(kf[5],qa_,C1,0,0,0),   P1[6],P1[7],P1[8],P1[9],     pw2[2]=PKW(P1,4), pw2[3]=PKW(P1,6), pw2); \
    VRD(3); SBAR(); GAPA(C0=__builtin_amdgcn_mfma_f32_32x32x16_bf16(kf[6],qb_,C0,0,0,0),   P1[10],P1[11],P1[12],P1[13], pw3[0]=PKW(P1,8), pw3[1]=PKW(P1,10), pw3); \
    VRD(7); SBAR(); GAPA(C1=__builtin_amdgcn_mfma_f32_32x32x16_bf16(kf[7],qb_,C1,0,0,0),   P1[14],P1[15],0.f,0.f,       pw3[2]=PKW(P1,12),pw3[3]=PKW(P1,14), pw3); \
    l_reg+=sacc; \
    if(GK){DMA_K((t)+3,sl_cur);} if(GV){DMA_V((t)+1,sl_next);} \
    CMASK(C0,C1,t); \
    { float a=MX3(C0[0],C0[1],C1[0]),b=MX3(C0[2],C0[3],C1[1]); a=MX3(a,C1[2],C1[3]); \
      _Pragma("unroll") for(int r=4;r<16;r+=4){a=MX3(a,C0[r],C0[r+1]);b=MX3(b,C0[r+2],C0[r+3]);a=MX3(a,C1[r],C1[r+1]);b=MX3(b,C1[r+2],C1[r+3]);} \
      float rm=__builtin_fmaxf(a,b); { auto rr=__builtin_amdgcn_permlane32_swap(__float_as_uint(rm),__float_as_uint(rm),false,false); rm=__builtin_fmaxf(__uint_as_float(rr[0]),__uint_as_float(rr[1])); } \
      resc=false; \
      if(__builtin_expect(__any(rm>(float)THRL),0)){ const float dl=__builtin_fmaxf(rm,0.f); mhat+=dl; \
        _Pragma("unroll") for(int r=0;r<16;++r){C0[r]-=dl;C1[r]-=dl;} \
        _Pragma("unroll") for(int r=0;r<16;++r)negm[r]=-mhat; asm volatile("":"+v"(negm)); \
        const float f=__builtin_amdgcn_exp2f(-dl); l_reg*=f; if(hi==0)wsf[r32]=f; resc=true; } } \
    SBAR(); \
    GAPB(o[0]=__builtin_amdgcn_mfma_f32_32x32x16_bf16(PAF(0),VFR(0),o[0],0,0,0), C0,0,  VRD2(0)); \
    GAPB(o[1]=__builtin_amdgcn_mfma_f32_32x32x16_bf16(PAF(0),VFR(4),o[1],0,0,0), C0,2,  VRD2(4)); \
    GAPB(o[0]=__builtin_amdgcn_mfma_f32_32x32x16_bf16(PAF(1),VFR(1),o[0],0,0,0), C0,4,  VRD2(1)); \
    GAPB(o[1]=__builtin_amdgcn_mfma_f32_32x32x16_bf16(PAF(1),VFR(5),o[1],0,0,0), C0,6,  VRD2(5)); \
    GAPB(o[0]=__builtin_amdgcn_mfma_f32_32x32x16_bf16(PAF(2),VFR(2),o[0],0,0,0), C0,8,  VRD2(2)); \
    GAPB(o[1]=__builtin_amdgcn_mfma_f32_32x32x16_bf16(PAF(2),VFR(6),o[1],0,0,0), C0,10, VRD2(6)); \
    GAPB(o[0]=__builtin_amdgcn_mfma_f32_32x32x16_bf16(PAF(3),VFR(3),o[0],0,0,0), C0,12, VRD2(3)); \
    GAPB(o[1]=__builtin_amdgcn_mfma_f32_32x32x16_bf16(PAF(3),VFR(7),o[1],0,0,0), C0,14, VRD2(7)); \
    GAPB(o[2]=__builtin_amdgcn_mfma_f32_32x32x16_bf16(PAF(0),VFR(0),o[2],0,0,0), C1,0,  NORD); \
    GAPB(o[3]=__builtin_amdgcn_mfma_f32_32x32x16_bf16(PAF(0),VFR(4),o[3],0,0,0), C1,2,  NORD); \
    KRD(GL,0); GAPB(o[2]=__builtin_amdgcn_mfma_f32_32x32x16_bf16(PAF(1),VFR(1),o[2],0,0,0), C1,4,  NORD); \
    KRD(GL,1); GAPB(o[3]=__builtin_amdgcn_mfma_f32_32x32x16_bf16(PAF(1),VFR(5),o[3],0,0,0), C1,6,  NORD); \
    KRD(GL,2); GAPB(o[2]=__builtin_amdgcn_mfma_f32_32x32x16_bf16(PAF(2),VFR(2),o[2],0,0,0), C1,8,  NORD); \
    KRD(GL,3); GAPB(o[3]=__builtin_amdgcn_mfma_f32_32x32x16_bf16(PAF(2),VFR(6),o[3],0,0,0), C1,10, NORD); \
    GAPB(o[2]=__builtin_amdgcn_mfma_f32_32x32x16_bf16(PAF(3),VFR(3),o[2],0,0,0), C1,12, NORD); \
    GAPB(o[3]=__builtin_amdgcn_mfma_f32_32x32x16_bf16(PAF(3),VFR(7),o[3],0,0,0), C1,14, NORD); \
    }while(0)
  int t=1;
  #undef CMASK
  #define CMASK(P0,P1,t) do{}while(0)
  for(;t+5<NT;t+=2){
    STEP(pB0,pB1,pA0,pA1,t,true,true,true);     WAIT_BAR(3); RESC(); ROT();
    STEP(pA0,pA1,pB0,pB1,t+1,true,true,true);   WAIT_BAR(3); RESC(); ROT();
  }
  #undef CMASK
  #define CMASK(P0,P1,t) do{ if(MODE==0){int jb_=(t)-(NT-4); if(jb_>=0)cmask(P0,P1,jb_,qrel,hi);} else smask(P0,P1,(t),qrel,hi,shift); }while(0)
  #define ENDW(tt) do{ if((tt)+3<NT){WAIT_BAR(3);} else if((tt)+2<NT){WAIT_BAR(2);} else {WAIT_BAR(0);} }while(0)
  for(;t+1<NT;t+=2){
    STEP(pB0,pB1,pA0,pA1,t,(t+3<NT),(t+1<NT),(t+1<NT));       ENDW(t);   RESC(); ROT();
    STEP(pA0,pA1,pB0,pB1,t+1,(t+4<NT),(t+2<NT),(t+2<NT));     ENDW(t+1); RESC(); ROT();
  }
  STEP(pB0,pB1,pA0,pA1,NT-1,false,false,false); RESC();
  { float sacc=pB0[0]+pB0[1]; _Pragma("unroll") for(int r=2;r<16;++r)sacc+=pB0[r]; _Pragma("unroll") for(int r=0;r<16;++r)sacc+=pB1[r]; l_reg+=sacc;
    pw0=(u32x4){PKW(pB0,0),PKW(pB0,2),PKW(pB0,4),PKW(pB0,6)};pw1=(u32x4){PKW(pB0,8),PKW(pB0,10),PKW(pB0,12),PKW(pB0,14)};pw2=(u32x4){PKW(pB1,0),PKW(pB1,2),PKW(pB1,4),PKW(pB1,6)};pw3=(u32x4){PKW(pB1,8),PKW(pB1,10),PKW(pB1,12),PKW(pB1,14)};
    SBAR(); pv(o,vb0+2*sl_cur,PAF(0),PAF(1),PAF(2),PAF(3)); pv(o+2,vb0+2*sl_cur+8192,PAF(0),PAF(1),PAF(2),PAF(3)); }
  #undef PKW
  #undef PAF
  #undef VFR
  #undef PIN
  #undef MX3
  #undef GAPA
  #undef GAPB
  #undef EX
  #undef VRD
  #undef VRD2
  #undef NORD
  #undef QF
  #undef KRD
  #undef STEP
  #undef ENDW
  {auto rr=__builtin_amdgcn_permlane32_swap(__float_as_uint(l_reg),__float_as_uint(l_reg),false,false);l_reg=__uint_as_float(rr[0])+__uint_as_float(rr[1]);}
  if(hi==0)wsf[32+r32]=l_reg;asm volatile("s_waitcnt lgkmcnt(0)":::"memory");
  float rli[16];
  #pragma unroll
  for(int r=0;r<16;++r)rli[r]=__builtin_amdgcn_rcpf(wsf[32+crow(r,hi)]);
  bf16*Ow=Ou+(long)(wid*QBLK)*opitch;
  { bf16*stg=(bf16*)(shm+N_LDS_OST)+wid*4096;
    #pragma unroll
    for(int r=0;r<16;++r){const int orow=crow(r,hi);
      #pragma unroll
      for(int d0=0;d0<4;++d0)stg[orow*128+d0*32+r32]=(bf16)(cvtpk_s(o[d0][r]*rli[r],0.f)&0xffffu);}
    asm volatile("s_waitcnt lgkmcnt(0)":::"memory");
    #pragma unroll
    for(int i=0;i<8;++i){const int row=i*4+(lane>>4),ch=lane&15; const u32x4 v=*(const u32x4*)(stg+row*128+ch*8); ATTN_STORE16(Ow+(long)row*opitch+ch*8,v);} }
  asm volatile("s_waitcnt lgkmcnt(0)\n\ts_barrier":::"memory");
  #undef DMA_K
  #undef DMA_V
  #undef CMASK
  #undef START
  #undef RESC
  #undef ROT
}
constexpr int ATTN_LDS_BYTES=LDS_BYTES;
#undef SBAR
#undef WAIT_BAR
}
constexpr int NWAVES = 8;
constexpr int RING_BYTES = 131072;
constexpr int TBL_OFF = 140 * 1024;
constexpr int MISC_OFF = 143 * 1024;
constexpr int LDS_BYTES = 147456;
static_assert(ROUTER_LDS <= TBL_OFF && attn_body::ATTN_LDS_BYTES <= RING_BYTES && attn_body::N_LDS_BYTES <= TBL_OFF, "LDS map");
constexpr int CW_BAR = 4096;
constexpr int MAX_LAUNCHES = 12;

#define GAS __attribute__((address_space(1)))
#define LAS __attribute__((address_space(3)))
typedef GAS unsigned gu32;
#define RLX_AGENT __ATOMIC_RELAXED, __HIP_MEMORY_SCOPE_AGENT
#define XB_TMO      128
#define XB_XCNT(j)  (256  + 64 * (j))
#define XB_XSUB(j)  (1280 + 64 * (j))
#define XB_XGEN(j)  (2304 + 64 * (j))
#define XB_TOP      3328
#define XB_TOPGEN   3392
#define XCD_BAR_WORDS 3456
#define XB_SPIN_CAP (1u << 18)

__device__ __forceinline__ unsigned xb_ld(unsigned* p)              { return __hip_atomic_load(p, __ATOMIC_RELAXED, __HIP_MEMORY_SCOPE_AGENT); }
__device__ __forceinline__ unsigned xb_add(unsigned* p, unsigned v) { return __hip_atomic_fetch_add(p, v, __ATOMIC_RELAXED, __HIP_MEMORY_SCOPE_AGENT); }
__device__ __forceinline__ unsigned xb_xcc_id() { return (unsigned)__builtin_amdgcn_s_getreg((3 << 11) | 20) & 0xFu; }
#define XB_SPIN(cond, bar) do { unsigned _sp = 0; while (cond) { __builtin_amdgcn_s_sleep(1); \
    if ((++_sp & 255u) == 0u) { if (xb_ld(&(bar)[XB_TMO])) break; if (_sp > XB_SPIN_CAP) { atomicAdd(&(bar)[XB_TMO], 1u); break; } } } } while (0)

struct XcdBarrier {
    unsigned* bar; unsigned x;
    volatile LAS unsigned* st;
};

__device__ __forceinline__ XcdBarrier xcd_barrier_post(unsigned* bar, volatile LAS unsigned* st) {
    XcdBarrier b; b.bar = bar; b.x = xb_xcc_id(); b.st = st;
    if (threadIdx.x == 0) (void)xb_add(&bar[XB_XCNT(b.x)], 1u);
    return b;
}
__device__ __forceinline__ void xcd_barrier_complete(unsigned* bar, unsigned x, unsigned& nloc, unsigned& nx) {
    const unsigned G = gridDim.x * gridDim.y * gridDim.z;
    unsigned sum, cnt, mine, sp = 0u;
    for (;;) {
        sum = 0u; cnt = 0u; mine = 0u;
#pragma unroll
        for (unsigned j = 0; j < 16; ++j) { const unsigned c = xb_ld(&bar[XB_XCNT(j)]); sum += c; cnt += (c > 0u) ? 1u : 0u; mine = (j == x) ? c : mine; }
        if (sum == G) break;
        __builtin_amdgcn_s_sleep(1);
        if ((++sp & 255u) == 0u) { if (xb_ld(&bar[XB_TMO])) break; if (sp > XB_SPIN_CAP) { atomicAdd(&bar[XB_TMO], 1u); break; } }
    }
    nloc = mine > 0u ? mine : 1u; nx = cnt > 0u ? cnt : 1u;
}

__device__ __forceinline__ void xcd_barrier(const XcdBarrier& b) {
    asm volatile("s_waitcnt vmcnt(0)" ::: "memory");
    __syncthreads();
    if (threadIdx.x == 0) {
        unsigned* bar = b.bar;
        __builtin_amdgcn_s_waitcnt(0);
        unsigned nloc = b.st[0], nx = b.st[1];
        if (nloc == 0u) { xcd_barrier_complete(bar, b.x, nloc, nx); b.st[0] = nloc; b.st[1] = nx; }
        const unsigned old = xb_add(&bar[XB_XSUB(b.x)], 1u);
        const unsigned gen = old / nloc;
        if (old + 1u == (gen + 1u) * nloc) {
            __builtin_amdgcn_fence(__ATOMIC_RELEASE, "agent");
            asm volatile("s_waitcnt vmcnt(0)" ::: "memory");
            const unsigned og = xb_add(&bar[XB_TOP], 1u);
            const unsigned tg = og / nx;
            if (og + 1u == (tg + 1u) * nx) xb_add(&bar[XB_TOPGEN], 1u);
            else XB_SPIN(xb_ld(&bar[XB_TOPGEN]) == tg, bar);
            __builtin_amdgcn_fence(__ATOMIC_ACQUIRE, "agent");
            xb_add(&bar[XB_XGEN(b.x)], 1u);
            asm volatile("s_waitcnt vmcnt(0)" ::: "memory");
        } else {
            XB_SPIN(xb_ld(&bar[XB_XGEN(b.x)]) == gen, bar);
            __builtin_amdgcn_fence(__ATOMIC_ACQUIRE, "agent");
            asm volatile("s_waitcnt vmcnt(0)" ::: "memory");
        }
    }
    __syncthreads();
}


static_assert((CW_BAR + MAX_LAUNCHES * XCD_BAR_WORDS) * 4 <= (int)CTL_ZERO_BYTES, "barrier words inside the memset region");

__device__ __forceinline__ void convert_w2_dynamic(const Params& p, volatile LAS unsigned* MISC, int maxchunks) {
    const int tid = threadIdx.x, lane = tid & 63, wave = tid >> 6; unsigned* cur = (unsigned*)(p.ws + WS_CTL) + CW_W2CUR;
    constexpr int NDYN = NEXP * TI_W2 - PREP_W2_ITEMS;
    for (int n = 0; maxchunks < 0 || n < maxchunks; ++n) {
        __syncthreads();
        if (tid == 0) MISC[16] = atomicAdd(cur, (unsigned)W2_CHUNK);
        __syncthreads();
        const int start = (int)MISC[16]; if (start >= NDYN) break;
        const int lo = TI_W2_START + PREP_W2_ITEMS + start, hi = TI_W2_START + PREP_W2_ITEMS + (start + W2_CHUNK < NDYN ? start + W2_CHUNK : NDYN);
        transpose_items(p, lo, hi, wave, 8, lane);
    }
}
__device__ __forceinline__ void phase_inproj(const Params& p, LAS unsigned char* lds, int G, int bid) {
    pg8::Gemm g{(const bf16_t*)(p.ws + WS_H1), (const bf16_t*)(p.ws + WS_WIN), DM, 0};
    pg8::StaticOrder S; S.init(NTOK, NPROJ, G, bid);
    pg8::EpiProj E{(bf16_t*)(p.ws + WS_PROJ), (const float*)(p.ws + WS_BINP), (const float*)(p.ws + WS_ROPE), (const float*)(p.ws + WS_ROPE) + (size_t)NTOK * 32};
    pg8::gemm_phase<pg8::EpiProj, pg8::StaticOrder, false>(lds, g, S, E);
    if (S.nwg % G != 0 && bid >= S.nwg % G) convert_w2_dynamic(p, (volatile LAS unsigned*)(lds + MISC_OFF), 1);
}
__device__ __forceinline__ void phase_attn(const Params& p, char* lds, int G, int bid) {
    const int vcu = (G % 8 == 0) ? (bid % 8) * (G / 8) + bid / 8 : bid;
    const attn_body::bf16* proj = (const attn_body::bf16*)(p.ws + WS_PROJ);
    for (int v = vcu; v < 256; v += G) {
        const int bhm = v >> 4, s = v & 15, b = bhm >> 3, hm = bhm & 7;
        const attn_body::bf16* rowb = proj + (size_t)b * SEQ * NPROJ;
#pragma unroll 1
        for (int i = 0; i < 2; ++i) { const int qb = i ? 31 - s : s;
            attn_body::attn_unit128<8>(rowb + (size_t)qb * 256 * NPROJ + PC_QD + hm * 64, rowb + PC_KD + hm * 64, rowb + PC_VD + (hm >> 1) * 128,
                                       (attn_body::bf16*)(p.ws + WS_OV) + ((size_t)b * SEQ + qb * 256) * DM + hm * 128, DM, 4 * (qb + 1), lds); }
    }
#pragma unroll 1
    for (int w = vcu; w < 512; w += G) {
        const int b = w >> 8, hq = (w >> 5) & 7, qb = w & 31, shift = qb ? 128 : 0;
        const attn_body::bf16* rowb = proj + (size_t)b * SEQ * NPROJ; const size_t krow = (size_t)(qb * 256 - shift) * NPROJ;
        attn_body::attn_unit<8, 1>(rowb + (size_t)qb * 256 * NPROJ + PC_QA + hq * 64, rowb + krow + PC_KA + (hq >> 2) * 64, rowb + krow + PC_VA + (hq >> 2) * 64,
                                   (attn_body::bf16*)(p.ws + WS_MIXED) + ((size_t)b * SEQ + qb * 256) * DM + hq * 64, DM, qb ? 6 : 4, shift, p.sinks[hq] * LOG2E, lds);
    }
}
__device__ __forceinline__ void phase_outproj(const Params& p, LAS unsigned char* lds, int G, int bid) {
    pg8::Gemm g{(const bf16_t*)(p.ws + WS_MIXED), (const bf16_t*)(p.ws + WS_WOUT), DM, 0};
    pg8::StaticOrder S; S.init(NTOK, DM, G, bid);
    pg8::EpiX1 E{p.x, (const float*)(p.ws + WS_MOD), p.b_out, (float*)(p.ws + WS_X1)};
    pg8::gemm_phase<pg8::EpiX1, pg8::StaticOrder, false>(lds, g, S, E);
}
__device__ __forceinline__ void build_tile_table(const Params& p, LAS unsigned char* lds) {
    LAS int* tb = (LAS int*)(lds + TBL_OFF); LAS int* cn = (LAS int*)(lds + TBL_OFF + 256);
    const unsigned* cnt = (const unsigned*)(p.ws + WS_CTL) + CW_CNT;
    __syncthreads();
    if (threadIdx.x == 0) { int a = 0; for (int e = 0; e < NEXP; ++e) { const int c = (int)__hip_atomic_load(cnt + e, RLX_AGENT); tb[e] = a; cn[e] = c; a += (c + 255) >> 8; } tb[NEXP] = a; }
    __syncthreads();
}
__device__ __forceinline__ void phase_gemm1(const Params& p, LAS unsigned char* lds, int G, int bid) {
    build_tile_table(p, lds);
    pg8::Gemm g{(const bf16_t*)(p.ws + WS_H2), (const bf16_t*)(p.ws + WS_W1), DM, (size_t)2 * DFF * DM};
    pg8::GroupedOrder S; S.init((const LAS int*)(lds + TBL_OFF), (const LAS int*)(lds + TBL_OFF + 256), (const int*)(p.ws + WS_LIST), 2 * DFF / 256, G, bid);
    pg8::EpiSwiglu E{p.b1, (bf16_t*)(p.ws + WS_ACT)};
    pg8::gemm_phase<pg8::EpiSwiglu, pg8::GroupedOrder, true>(lds, g, S, E);
    convert_w2_dynamic(p, (volatile LAS unsigned*)(lds + MISC_OFF), -1);
}
__device__ __forceinline__ void phase_gemm2(const Params& p, LAS unsigned char* lds, int G, int bid) {
    build_tile_table(p, lds);
    pg8::Gemm g{(const bf16_t*)(p.ws + WS_ACT), (const bf16_t*)(p.ws + WS_W2), DFF, (size_t)DM * DFF};
    pg8::GroupedOrder S; S.init((const LAS int*)(lds + TBL_OFF), (const LAS int*)(lds + TBL_OFF + 256), (const int*)(p.ws + WS_LIST), DM / 256, G, bid);
    pg8::EpiY E{p.b2, (bf16_t*)(p.ws + WS_Y)};
    pg8::gemm_phase<pg8::EpiY, pg8::GroupedOrder, false>(lds, g, S, E);
}

#ifndef REPEAT_PHASE
#define REPEAT_PHASE -1
#endif
constexpr int NPHASE = 10;
struct Args { Params p; int ph_lo, ph_hi, li, pad; };
__global__ void __launch_bounds__(NWAVES * 64, 2) mega(Args args) {
    extern __shared__ __attribute__((aligned(16))) unsigned char lds[];
    const Params& p = args.p;
    LAS unsigned char* L = (LAS unsigned char*)lds;
    volatile LAS unsigned* MISC = (volatile LAS unsigned*)(L + MISC_OFF);
    const int tid = threadIdx.x, G = gridDim.x, bid = blockIdx.x;
    for (int u = tid; u < (LDS_BYTES - MISC_OFF) / 4; u += NWAVES * 64) ((LAS unsigned*)(L + MISC_OFF))[u] = 0u;
    __syncthreads();
    XcdBarrier bar = xcd_barrier_post((unsigned*)(p.ws + WS_CTL) + CW_BAR + args.li * XCD_BAR_WORDS, MISC + 8);
    const int lo = args.ph_lo, hi = args.ph_hi;
#ifndef CMASKP
#define CMASKP 0x3ff
#endif
#define IN(k) (((CMASKP >> (k)) & 1) && lo <= (k) && (k) < hi)
#define SEAM(k) do { if (IN(k) && IN((k) + 1)) xcd_barrier(bar); } while (0)
#define RUNPH(k, call) do { if (IN(k)) { call; if (REPEAT_PHASE == (k)) { xcd_barrier(bar); call; } } } while (0)
    RUNPH(0, phase_prep(p, bid, G, (float*)lds)); SEAM(0);
    RUNPH(1, phase_h1(p, bid, G)); SEAM(1);
    RUNPH(2, phase_inproj(p, L, G, bid)); SEAM(2);
    RUNPH(3, phase_attn(p, (char*)lds, G, bid)); SEAM(3);
    RUNPH(4, phase_combine(p, bid, G)); SEAM(4);
    RUNPH(5, phase_outproj(p, L, G, bid)); SEAM(5);
    if (IN(6)) { phase_router(p, bid, G, lds);
        if (REPEAT_PHASE == 6) { xcd_barrier(bar); if (bid == 0 && tid < 32) ((unsigned*)(p.ws + WS_CTL))[CW_CNT + tid] = 0u; xcd_barrier(bar); phase_router(p, bid, G, lds); } } SEAM(6);
    RUNPH(7, phase_gemm1(p, L, G, bid)); SEAM(7);
    RUNPH(8, phase_gemm2(p, L, G, bid)); SEAM(8);
    RUNPH(9, phase_final(p, bid, G));
    if (REPEAT_PHASE == 99) { for (int i = 0; i < 10; ++i) xcd_barrier(bar); }
#undef RUNPH
#undef IN
#undef SEAM
}

template <class Epi>
__global__ __launch_bounds__(256) void ngemm(const bf16_t* __restrict__ A, const bf16_t* __restrict__ Bt, int K, const int* __restrict__ rowmap,
                                             const int* __restrict__ tiles, size_t bstride, Epi epi) {
    __shared__ __attribute__((aligned(16))) bf16_t sA[64][40];
    __shared__ __attribute__((aligned(16))) bf16_t sB[64][40];
    const int bm = blockIdx.y * 64, bn = blockIdx.x * 64, tid = threadIdx.x, lane = tid & 63, w = tid >> 6, wr = w >> 1, wc = w & 1, fr = lane & 15, quad = lane >> 4;
    int expert = 0;
    if (tiles) { if (bm / 256 >= tiles[0]) return; expert = tiles[16 + bm / 256]; }
    const bf16_t* Bb = Bt + (size_t)expert * bstride;
    const int lr = tid >> 2, lc = (tid & 3) * 8;
    const int arow = rowmap ? rowmap[bm + lr] : bm + lr;
    const bf16_t* ap = A + (size_t)arow * K + lc; const bf16_t* bp = Bb + (size_t)(bn + lr) * K + lc;
    f32x4 acc[2][2];
#pragma unroll
    for (int i = 0; i < 2; ++i)
#pragma unroll
        for (int j = 0; j < 2; ++j) acc[i][j] = (f32x4){0.f, 0.f, 0.f, 0.f};
    for (int k0 = 0; k0 < K; k0 += 32) {
        *(u32x4*)&sA[lr][lc] = *(const u32x4*)(ap + k0); *(u32x4*)&sB[lr][lc] = *(const u32x4*)(bp + k0);
        __syncthreads();
        bf16x8 a[2], b[2];
#pragma unroll
        for (int i = 0; i < 2; ++i) { a[i] = *(const bf16x8*)&sA[wr * 32 + i * 16 + fr][quad * 8]; b[i] = *(const bf16x8*)&sB[wc * 32 + i * 16 + fr][quad * 8]; }
#pragma unroll
        for (int i = 0; i < 2; ++i)
#pragma unroll
            for (int j = 0; j < 2; ++j) acc[i][j] = __builtin_amdgcn_mfma_f32_16x16x32_bf16(a[i], b[j], acc[i][j], 0, 0, 0);
        __syncthreads();
    }
#pragma unroll
    for (int i = 0; i < 2; ++i)
#pragma unroll
        for (int j = 0; j < 2; ++j)
#pragma unroll
            for (int r = 0; r < 4; ++r) epi(bm + wr * 32 + i * 16 + quad * 4 + r, bn + wc * 32 + j * 16 + fr, acc[i][j][r], expert);
}
struct EpiProjN {
    const float* bias; const float* ropec; const float* ropes; bf16_t* out;
    __device__ __forceinline__ void operator()(int row, int col, float v, int) const {
        v += bias[col];
        const float other = __shfl_xor(v, 1);
        if (col < PC_ROPE_END) { const int f = (col & 63) >> 1; const float c = ropec[row * 32 + f], s = ropes[row * 32 + f];
            v = (col & 1) ? (v * c + other * s) : (v * c - other * s);
            if (col < PC_KA || (col >= PC_QD && col < PC_KD)) v *= C2; }
        out[(size_t)row * NPROJ + col] = (bf16_t)f2bf(v);
    }
};
struct EpiX1N {
    const float* x; const float* mod; const float* bias; float* out;
    __device__ __forceinline__ void operator()(int row, int col, float v, int) const {
        const int b = row / SEQ; out[(size_t)row * DM + col] = x[(size_t)row * DM + col] + mod[b * (NMOD * DM) + 2 * DM + col] * (v + bias[col]);
    }
};
struct EpiSwigluN {
    const float* b1; bf16_t* act;
    __device__ __forceinline__ void operator()(int row, int col, float v, int e) const {
        v += b1[(size_t)e * 2 * DFF + col];
        const float other = __shfl_xor(v, 1);
        if (!(col & 1)) { const float g = fminf(v, 7.0f), l = fminf(fmaxf(other, -7.0f), 7.0f);
            act[(size_t)row * DFF + (col >> 1)] = (bf16_t)f2bf(g / (1.0f + __expf(-1.702f * g)) * (l + 1.0f)); }
    }
};
struct EpiYN {
    const float* b2; bf16_t* y;
    __device__ __forceinline__ void operator()(int row, int col, float v, int e) const { y[(size_t)row * DM + col] = (bf16_t)f2bf(v + b2[(size_t)e * DM + col]); }
};

template <int MODE>
__global__ __launch_bounds__(64) void nattn(const bf16_t* __restrict__ proj, bf16_t* __restrict__ out, const float* __restrict__ sinks) {
    const int lane = threadIdx.x, row = blockIdx.x * 64 + lane, t = row % SEQ, rowb = row - t, t0 = (blockIdx.x * 64) % SEQ, hd = blockIdx.y;
    int qcol, kcol, vcol, ocol, opitch;
    if (MODE == 0) { const int hm = hd >> 1, half = hd & 1; qcol = PC_QD + hm * 64; kcol = PC_KD + hm * 64; vcol = PC_VD + (hm >> 1) * 128 + half * 64; ocol = hd * 64; opitch = DM; }
    else { qcol = PC_QA + hd * 64; kcol = PC_KA + (hd >> 2) * 64; vcol = PC_VA + (hd >> 2) * 64; ocol = hd * 64; opitch = DM; }
    float q[64], o[64];
#pragma unroll
    for (int i = 0; i < 8; ++i) { const u32x4 w = *(const u32x4*)(proj + (size_t)row * NPROJ + qcol + i * 8);
#pragma unroll
        for (int j = 0; j < 4; ++j) { q[i * 8 + 2 * j] = bflo(w[j]); q[i * 8 + 2 * j + 1] = bfhi(w[j]); } }
#pragma unroll
    for (int i = 0; i < 64; ++i) o[i] = 0.f;
    float m, l;
    if (MODE == 1) { m = sinks[hd] * LOG2E; l = 1.0f; } else { m = -INFINITY; l = 0.f; }
    const int jlo = MODE == 1 ? (t0 - 127 < 0 ? 0 : t0 - 127) : 0, jhi = t0 + 63;
    for (int j = jlo; j <= jhi; ++j) {
        const bf16_t* kr = proj + (size_t)(rowb + j) * NPROJ + kcol; const bf16_t* vr = proj + (size_t)(rowb + j) * NPROJ + vcol;
        float s = 0.f;
#pragma unroll
        for (int i = 0; i < 8; ++i) { const u32x4 w = *(const u32x4*)(kr + i * 8);
#pragma unroll
            for (int jj = 0; jj < 4; ++jj) { s += q[i * 8 + 2 * jj] * bflo(w[jj]); s += q[i * 8 + 2 * jj + 1] * bfhi(w[jj]); } }
        const bool vis = (j <= t) && (MODE == 0 || (t - j) < 128);
        if (!vis) s = -INFINITY;
        const float mn = fmaxf(m, s);
        if (mn == -INFINITY) continue;
        const float alpha = exp2f(m - mn), pj = exp2f(s - mn);
        l = l * alpha + pj; m = mn;
#pragma unroll
        for (int i = 0; i < 8; ++i) { const u32x4 w = *(const u32x4*)(vr + i * 8);
#pragma unroll
            for (int jj = 0; jj < 4; ++jj) { o[i * 8 + 2 * jj] = o[i * 8 + 2 * jj] * alpha + pj * bflo(w[jj]); o[i * 8 + 2 * jj + 1] = o[i * 8 + 2 * jj + 1] * alpha + pj * bfhi(w[jj]); } }
    }
    const float rl = 1.0f / l;
#pragma unroll
    for (int i = 0; i < 8; ++i) { u32x4 w;
#pragma unroll
        for (int jj = 0; jj < 4; ++jj) w[jj] = pk2(o[i * 8 + 2 * jj] * rl, o[i * 8 + 2 * jj + 1] * rl);
        *(u32x4*)(out + (size_t)row * opitch + ocol + i * 8) = w; }
}

__global__ void k_tiles(Params p) {
    const unsigned* cnt = (const unsigned*)(p.ws + WS_CTL) + CW_CNT; int* tl = (int*)(p.ws + WS_TILES); int* rowmap = (int*)(p.ws + WS_ROWMAP); const int* list = (const int*)(p.ws + WS_LIST);
    __shared__ int tb[33];
    if (threadIdx.x == 0) { int a = 0; for (int e = 0; e < 32; ++e) { tb[e] = a; a += (int)((cnt[e] + 255u) >> 8); } tb[32] = a; tl[0] = a; }
    __syncthreads();
    for (int t = blockIdx.x; t < tb[32]; t += gridDim.x) {
        int e = 0; while (t >= tb[e + 1]) ++e;
        const int mt = t - tb[e];
        if (threadIdx.x == 0) { tl[16 + t] = e; tl[512 + t] = mt; }
        for (int r = threadIdx.x; r < 256; r += blockDim.x) { const int pos = mt * 256 + r; rowmap[t * 256 + r] = pos < (int)cnt[e] ? list[e * NTOK + pos] : 0; }
    }
}


#ifndef FAST_MASK
#define FAST_MASK 0x3ff
#endif
#ifndef SINGLE
#define SINGLE 1
#endif
extern "C" void kernel_launch(void* const* d_in, const int* in_sizes, int n_in, void* d_out, int out_size, void* d_ws, size_t ws_size, hipStream_t stream) {
    static int grid = 0;
    if (grid == 0) {
        if (n_in != 24 || in_sizes[0] != NTOK * DM || out_size != NTOK * DM || ws_size < WS_END) { fprintf(stderr, "kernel_launch: unexpected shapes (n_in %d in0 %d out %d ws %zu)\n", n_in, n_in > 0 ? in_sizes[0] : -1, out_size, ws_size); grid = -1; return; }
        int dev = 0, cus = 0, per_cu = 0;
        if (hipGetDevice(&dev) != hipSuccess || hipDeviceGetAttribute(&cus, hipDeviceAttributeMultiprocessorCount, dev) != hipSuccess) { fprintf(stderr, "kernel_launch: device query failed\n"); grid = -1; return; }
        if (hipFuncSetAttribute((const void*)mega, hipFuncAttributeMaxDynamicSharedMemorySize, LDS_BYTES) != hipSuccess) { fprintf(stderr, "kernel_launch: hipFuncSetAttribute(mega) failed\n"); grid = -1; return; }
        if (hipOccupancyMaxActiveBlocksPerMultiprocessor(&per_cu, (const void*)mega, NWAVES * 64, LDS_BYTES) != hipSuccess || per_cu < 1) { fprintf(stderr, "kernel_launch: occupancy query says %d blocks per CU\n", per_cu); }
        (void)hipGetLastError();
        grid = cus;
    }
    if (grid < 0) return;
    Params p{};
    p.x = (const float*)d_in[0]; p.c = (const float*)d_in[1]; p.pos = (const int*)d_in[2]; p.w_ada = (const float*)d_in[3]; p.b_ada = (const float*)d_in[4]; p.g_mix = (const float*)d_in[5];
    p.w_in = (const float*)d_in[6]; p.b_in = (const float*)d_in[7]; p.sinks = (const float*)d_in[8]; p.lq1 = (const float*)d_in[9]; p.lk1 = (const float*)d_in[10]; p.lq2 = (const float*)d_in[11];
    p.lk2 = (const float*)d_in[12]; p.g_subln = (const float*)d_in[13]; p.w_out = (const float*)d_in[14]; p.b_out = (const float*)d_in[15]; p.g_ffn = (const float*)d_in[16];
    p.w_router = (const float*)d_in[17]; p.b_router = (const float*)d_in[18]; p.w1 = (const float*)d_in[19]; p.b1 = (const float*)d_in[20]; p.w2 = (const float*)d_in[21]; p.b2 = (const float*)d_in[22];
    p.g_final = (const float*)d_in[23]; p.out = (float*)d_out; p.ws = (unsigned char*)d_ws;
    unsigned char* ws = p.ws;
    (void)hipMemsetAsync(ws + WS_CTL, 0, CTL_ZERO_BYTES, stream);
    int li = 0;
    auto launch_mega = [&](int lo, int hi) { Args a{}; a.p = p; a.ph_lo = lo; a.ph_hi = hi; a.li = li++; hipLaunchKernelGGL(mega, dim3(grid), dim3(NWAVES * 64), LDS_BYTES, stream, a); };
    if (FAST_MASK == 0x3ff && SINGLE) { launch_mega(0, NPHASE); return; }
    bool tiles_done = false;
    for (int k = 0; k < NPHASE; ++k) {
        if ((FAST_MASK >> k) & 1) { launch_mega(k, k + 1); continue; }
        if ((k == 7 || k == 8) && !tiles_done) { hipLaunchKernelGGL(k_tiles, dim3(MAXTILES), dim3(256), 0, stream, p); tiles_done = true; }
        switch (k) {
        case 2: { EpiProjN e{(const float*)(ws + WS_BINP), (const float*)(ws + WS_ROPE), (const float*)(ws + WS_ROPE) + (size_t)NTOK * 32, (bf16_t*)(ws + WS_PROJ)};
            hipLaunchKernelGGL(ngemm<EpiProjN>, dim3(NPROJ / 64, NTOK / 64), dim3(256), 0, stream, (const bf16_t*)(ws + WS_H1), (const bf16_t*)(ws + WS_WIN), DM, (const int*)nullptr, (const int*)nullptr, (size_t)0, e); } break;
        case 3: hipLaunchKernelGGL(nattn<1>, dim3(NTOK / 64, 8), dim3(64), 0, stream, (const bf16_t*)(ws + WS_PROJ), (bf16_t*)(ws + WS_MIXED), p.sinks);
            hipLaunchKernelGGL(nattn<0>, dim3(NTOK / 64, 16), dim3(64), 0, stream, (const bf16_t*)(ws + WS_PROJ), (bf16_t*)(ws + WS_OV), p.sinks); break;
        case 5: { EpiX1N e{p.x, (const float*)(ws + WS_MOD), p.b_out, (float*)(ws + WS_X1)};
            hipLaunchKernelGGL(ngemm<EpiX1N>, dim3(DM / 64, NTOK / 64), dim3(256), 0, stream, (const bf16_t*)(ws + WS_MIXED), (const bf16_t*)(ws + WS_WOUT), DM, (const int*)nullptr, (const int*)nullptr, (size_t)0, e); } break;
        case 7: { EpiSwigluN e{p.b1, (bf16_t*)(ws + WS_ACT)};
            hipLaunchKernelGGL(ngemm<EpiSwigluN>, dim3(2 * DFF / 64, MAXROWS / 64), dim3(256), 0, stream, (const bf16_t*)(ws + WS_H2), (const bf16_t*)(ws + WS_W1), DM, (const int*)(ws + WS_ROWMAP), (const int*)(ws + WS_TILES), (size_t)2 * DFF * DM, e); } break;
        case 8: { EpiYN e{p.b2, (bf16_t*)(ws + WS_Y)};
            hipLaunchKernelGGL(ngemm<EpiYN>, dim3(DM / 64, MAXROWS / 64), dim3(256), 0, stream, (const bf16_t*)(ws + WS_ACT), (const bf16_t*)(ws + WS_W2), DFF, (const int*)nullptr, (const int*)(ws + WS_TILES), (size_t)DM * DFF, e); } break;
        default: fprintf(stderr, "kernel_launch: phase %d has no naive form\n", k); break;
        }
    }
}
```

```cpp
#include <hip/hip_runtime.h>
#include <cstdint>
#include <cstdio>

constexpr int BATCH = 2, SEQ = 8192, NTOK = BATCH * SEQ, DM = 1024, NPROJ = 2304, NEXP = 32, TOPK = 4, DFF = 1024, NMOD = 6;
constexpr float EPS = 1e-5f;
constexpr float C2 = 0.125f * 1.4426950408889634f;
constexpr float LOG2E = 1.4426950408889634f;
constexpr float W8_SCALE = 64.0f;
constexpr float LAMBDA_INIT = 0.2f;
constexpr int PC_QA = 0, PC_KA = 512, PC_QD = 640, PC_KD = 1152, PC_VA = 1664, PC_VD = 1792, PC_ROPE_END = 1664;
constexpr int MAXTILES = 288;
constexpr int MAXROWS = MAXTILES * 256;

constexpr size_t MiB = 1u << 20;
constexpr size_t WS_CTL = 0, CTL_ZERO_BYTES = 256 * 1024;
constexpr size_t WS_MOD = 1 * MiB;
constexpr size_t WS_BINP = WS_MOD + 64 * 1024;
constexpr size_t WS_LAM = WS_BINP + 16 * 1024;
constexpr size_t WS_TILES = WS_LAM + 1024;
constexpr size_t WS_WRT = WS_MOD + 128 * 1024;
constexpr size_t WS_GAM2 = WS_MOD + 256 * 1024;
constexpr size_t WS_CB = WS_GAM2 + 8 * 1024;
constexpr size_t WS_ROPE = 2 * MiB;
constexpr size_t WS_PSUM = 6 * MiB + 512 * 1024;
constexpr size_t WS_WIN = 8 * MiB;
constexpr size_t WS_WOUT = 14 * MiB;
constexpr size_t WS_W1 = 16 * MiB;
constexpr size_t WS_W2 = 144 * MiB;
constexpr size_t WS_H1 = 208 * MiB;
constexpr size_t WS_PROJ = 240 * MiB;
constexpr size_t WS_OV = 312 * MiB;
constexpr size_t WS_MIXED = 344 * MiB;
constexpr size_t WS_X1 = 376 * MiB;
constexpr size_t WS_H2 = 440 * MiB;
constexpr size_t WS_GATE = 474 * MiB;
constexpr size_t WS_TOKPOS = WS_GATE + 256 * 1024;
constexpr size_t WS_LIST = 475 * MiB;
constexpr size_t WS_ROWMAP = 478 * MiB;
constexpr size_t WS_ACT = 480 * MiB;
constexpr size_t WS_Y = 624 * MiB;
constexpr size_t WS_END = 768 * MiB;
constexpr int CW_CNT = 64;
constexpr int CW_W2CUR = 128;

__constant__ float ROPE_INV[32] = {
    1.000000000e+00f, 7.498942018e-01f, 5.623413324e-01f, 4.216965139e-01f, 3.162277639e-01f, 2.371373922e-01f, 1.778279394e-01f, 1.333521456e-01f,
    1.000000015e-01f, 7.498941571e-02f, 5.623412877e-02f, 4.216964915e-02f, 3.162277862e-02f, 2.371373586e-02f, 1.778279431e-02f, 1.333521493e-02f,
    9.999999776e-03f, 7.498942316e-03f, 5.623413250e-03f, 4.216964822e-03f, 3.162277862e-03f, 2.371373819e-03f, 1.778279431e-03f, 1.333521446e-03f,
    1.000000047e-03f, 7.498941850e-04f, 5.623413017e-04f, 4.216965463e-04f, 3.162277862e-04f, 2.371373848e-04f, 1.778279402e-04f, 1.333521504e-04f};
typedef unsigned short bf16_t;
typedef float f32x4 __attribute__((ext_vector_type(4)));
typedef short bf16x8 __attribute__((ext_vector_type(8)));
typedef unsigned u32x4 __attribute__((ext_vector_type(4)));
typedef unsigned u32x2 __attribute__((ext_vector_type(2)));

__device__ __forceinline__ unsigned f2bf(float f) { unsigned u = __float_as_uint(f); return (u + 0x7fffu + ((u >> 16) & 1u)) >> 16; }
__device__ __forceinline__ unsigned pk2(float lo, float hi) { return f2bf(lo) | (f2bf(hi) << 16); }
__device__ __forceinline__ unsigned pk4_fp8(float a, float b, float c, float d) { int w = 0; w = __builtin_amdgcn_cvt_pk_fp8_f32(a, b, w, false); w = __builtin_amdgcn_cvt_pk_fp8_f32(c, d, w, true); return (unsigned)w; }
__device__ __forceinline__ float bf2f(unsigned h) { return __uint_as_float(h << 16); }
__device__ __forceinline__ float bflo(unsigned w) { return __uint_as_float(w << 16); }
__device__ __forceinline__ float bfhi(unsigned w) { return __uint_as_float(w & 0xffff0000u); }
__device__ __forceinline__ float wave_sum(float v) {
#pragma unroll
    for (int o = 1; o < 64; o <<= 1) v += __shfl_xor(v, o);
    return v;
}

struct Params {
    const float *x, *c; const int* pos; const float *w_ada, *b_ada, *g_mix, *w_in, *b_in, *sinks, *lq1, *lk1, *lq2, *lk2, *g_subln, *w_out, *b_out, *g_ffn,
        *w_router, *b_router, *w1, *b1, *w2, *b2, *g_final;
    float* out; unsigned char* ws;
};

__device__ __forceinline__ int proj_col_of_src(int s) {
    if (s < 640) { const int head = s >> 6, d = s & 63; return head * 64 + 2 * (d & 31) + (d >> 5); }
    if (s < 768) return PC_VA + (s - 640);
    if (s < 1792) { const int t = s - 768, head = t >> 6, d = t & 63; return PC_QD + head * 64 + 2 * (d & 31) + (d >> 5); }
    return s;
}

struct TItem { const float* src; bf16_t* dst; int N, K, n0; bool perm; };
constexpr int TI_IN = (DM / 64) * (NPROJ / 32), TI_OUT = (DM / 64) * (DM / 32), TI_TOTAL = TI_IN + TI_OUT;
__device__ __forceinline__ TItem titem_decode(const Params& p, int it, int lane) {
    const float* W; bf16_t* WT; int K, N; bool perm = false; int r = it;
    if (r < TI_IN) { W = p.w_in; WT = (bf16_t*)(p.ws + WS_WIN); K = DM; N = NPROJ; perm = true; }
    else { r -= TI_IN; W = p.w_out; WT = (bf16_t*)(p.ws + WS_WOUT); K = DM; N = DM; }
    const int nblk = N / 32, kb = r / nblk, nb = r - kb * nblk, k0 = 64 * kb + 8 * (lane >> 3), n0 = 32 * nb + 4 * (lane & 7);
    TItem t; t.src = W + (size_t)k0 * N + n0; t.dst = WT + k0; t.N = N; t.K = K; t.n0 = n0; t.perm = perm; return t;
}
struct T8Item { const float* src; unsigned char* dst; int N, K, n0; };
constexpr int T8_W1 = (DM / 128) * (2 * DFF / 32), T8_W2 = (DFF / 128) * (DM / 32), T8_W2_START = NEXP * T8_W1, T8_TOTAL = NEXP * (T8_W1 + T8_W2);
constexpr int PREP_W2_ITEMS = 1024, W2_CHUNK = 24;
__device__ __forceinline__ T8Item t8_decode(const Params& p, int it, int lane) {
    const float* W; unsigned char* WT; int K, N; int r = it;
    if (r < T8_W2_START) { const int e = r / T8_W1; r -= e * T8_W1; W = p.w1 + (size_t)e * DM * 2 * DFF; WT = p.ws + WS_W1 + (size_t)e * 2 * DFF * DM; K = DM; N = 2 * DFF; }
    else { r -= T8_W2_START; const int e = r / T8_W2; r -= e * T8_W2; W = p.w2 + (size_t)e * DFF * DM; WT = p.ws + WS_W2 + (size_t)e * DM * DFF; K = DFF; N = DM; }
    const int nblk = N / 32, kb = r / nblk, nb = r - kb * nblk, k0 = 128 * kb + 16 * (lane >> 3), n0 = 32 * nb + 4 * (lane & 7);
    T8Item t; t.src = W + (size_t)k0 * N + n0; t.dst = WT + k0; t.N = N; t.K = K; t.n0 = n0; return t;
}
__device__ __forceinline__ void t8_load(const T8Item& t, f32x4 (&v)[16]) {
#pragma unroll
    for (int kk = 0; kk < 16; ++kk) v[kk] = __builtin_nontemporal_load((const f32x4*)(t.src + (size_t)kk * t.N));
}
__device__ __forceinline__ void t8_store(const T8Item& t, const f32x4 (&v)[16]) {
#pragma unroll
    for (int i = 0; i < 4; ++i) {
        u32x4 o;
#pragma unroll
        for (int q = 0; q < 4; ++q) o[q] = pk4_fp8(v[4 * q][i] * W8_SCALE, v[4 * q + 1][i] * W8_SCALE, v[4 * q + 2][i] * W8_SCALE, v[4 * q + 3][i] * W8_SCALE);
        *(u32x4*)(t.dst + (size_t)(t.n0 + i) * t.K) = o;
    }
}
__device__ __forceinline__ void transpose8_items(const Params& p, int lo, int hi, int gw, int NGW, int lane) {
    int it = lo + gw; if (it >= hi) return;
    f32x4 va[16], vb[16]; T8Item A = t8_decode(p, it, lane), B = A; t8_load(A, va);
    for (;;) {
        const bool hasB = it + NGW < hi; if (hasB) { B = t8_decode(p, it + NGW, lane); t8_load(B, vb); }
        t8_store(A, va); if (!hasB) break;
        const bool hasA = it + 2 * NGW < hi; if (hasA) { A = t8_decode(p, it + 2 * NGW, lane); t8_load(A, va); }
        t8_store(B, vb); if (!hasA) break;
        it += 2 * NGW;
    }
}
__device__ __forceinline__ void titem_load(const TItem& t, f32x4 (&v)[16]) {
#pragma unroll
    for (int kk = 0; kk < 8; ++kk) { v[kk] = __builtin_nontemporal_load((const f32x4*)(t.src + (size_t)kk * t.N)); v[8 + kk] = __builtin_nontemporal_load((const f32x4*)(t.src + (size_t)kk * t.N + 32)); }
}
__device__ __forceinline__ void titem_store(const TItem& t, const f32x4 (&v)[16]) {
#pragma unroll
    for (int h = 0; h < 2; ++h)
#pragma unroll
        for (int i = 0; i < 4; ++i) {
            const int n = t.n0 + 32 * h + i, r = t.perm ? proj_col_of_src(n) : n;
            u32x4 o; o.x = pk2(v[8 * h + 0][i], v[8 * h + 1][i]); o.y = pk2(v[8 * h + 2][i], v[8 * h + 3][i]); o.z = pk2(v[8 * h + 4][i], v[8 * h + 5][i]); o.w = pk2(v[8 * h + 6][i], v[8 * h + 7][i]);
            *(u32x4*)(t.dst + (size_t)r * t.K) = o;
        }
}
__device__ __forceinline__ void transpose_items(const Params& p, int lo, int hi, int gw, int NGW, int lane) {
    int it = lo + 2 * gw; if (it >= hi) return;
    const int st = 2 * NGW;
    f32x4 va[16], vb[16]; TItem A = titem_decode(p, it, lane), B = A; titem_load(A, va);
    for (;;) {
        const bool hasB = it + st < hi; if (hasB) { B = titem_decode(p, it + st, lane); titem_load(B, vb); }
        titem_store(A, va); if (!hasB) break;
        const bool hasA = it + 2 * st < hi; if (hasA) { A = titem_decode(p, it + 2 * st, lane); titem_load(A, va); }
        titem_store(B, vb); if (!hasA) break;
        it += 2 * st;
    }
}

__device__ __forceinline__ void sincos_acc(float angf, float& s, float& c) {
    const double a = (double)angf;
    const double n = __builtin_rint(a * 0.63661977236758134308);
    double r = __builtin_fma(-n, 1.57079632679489655800e+00, a);
    r = __builtin_fma(-n, 6.12323399573676603587e-17, r);
    const double r2 = r * r;
    double sp = -2.5052108385441718775e-08; sp = sp * r2 + 2.7557319223985890653e-06; sp = sp * r2 - 1.9841269841269841253e-04; sp = sp * r2 + 8.3333333333333332177e-03;
    sp = sp * r2 - 1.6666666666666665741e-01; const double sn = r + r * r2 * sp;
    double cp = 2.0876756987868098979e-09; cp = cp * r2 - 2.7557319223985888276e-07; cp = cp * r2 + 2.4801587301587301566e-05; cp = cp * r2 - 1.3888888888888889419e-03;
    cp = cp * r2 + 4.1666666666666664354e-02; const double cs = 1.0 - 0.5 * r2 + r2 * r2 * cp;
    const int q = ((int)n) & 3;
    const double ss = (q & 1) ? cs : sn, cc = (q & 1) ? sn : cs;
    s = (float)((q & 2) ? -ss : ss); c = (float)(((q + 1) & 2) ? -cc : cc);
}

__device__ __forceinline__ void phase_prep(const Params& p, int bid, int nb, float* lds) {
    const int tid = threadIdx.x, lane = tid & 63, wave = tid >> 6;
    unsigned char* ws = p.ws;
    for (int jc = bid; jc < NMOD * DM / 64; jc += nb) {
        const int j = jc * 64 + lane; float a0 = 0.f, a1 = 0.f;
#pragma unroll 16
        for (int k = wave * 128; k < wave * 128 + 128; ++k) {
            const float c0 = p.c[k], c1 = p.c[DM + k];
            const float s0 = c0 / (1.f + __expf(-c0)), s1 = c1 / (1.f + __expf(-c1));
            const float w = p.w_ada[(size_t)k * (NMOD * DM) + j];
            a0 += s0 * w; a1 += s1 * w;
        }
        lds[(wave * 2 + 0) * 64 + lane] = a0; lds[(wave * 2 + 1) * 64 + lane] = a1;
        __syncthreads();
        if (wave < 2) { float s = 0.f;
#pragma unroll
            for (int w = 0; w < 8; ++w) s += lds[(w * 2 + wave) * 64 + lane];
            ((float*)(ws + WS_MOD))[wave * (NMOD * DM) + j] = s + p.b_ada[j]; }
        __syncthreads();
    }
    { float* ct = (float*)(ws + WS_ROPE); float* st = ct + (size_t)NTOK * 32;
        for (int i = bid * 512 + tid; i < NTOK * 32; i += nb * 512) {
            const int row = i >> 5, f = i & 31;
            const float ang = (float)p.pos[row] * ROPE_INV[f];
            float s, c; sincos_acc(ang, s, c); ct[i] = c; st[i] = s; } }
    if (bid == nb - 1) {
        float* bp = (float*)(ws + WS_BINP);
        for (int s = tid; s < NPROJ; s += 512) bp[proj_col_of_src(s)] = p.b_in[s];
        if (wave == 0) { const float a = wave_sum(p.lq1[lane] * p.lk1[lane]), b = wave_sum(p.lq2[lane] * p.lk2[lane]);
            if (lane == 0) *(float*)(ws + WS_LAM) = expf(a) - expf(b) + LAMBDA_INIT; }
    }
    for (int i = bid * 512 + tid; i < DM * NEXP; i += nb * 512) { const int k = i >> 5, e = i & 31; ((float*)(ws + WS_WRT))[e * DM + k] = p.w_router[i]; }
    transpose_items(p, 0, TI_TOTAL, bid * 8 + wave, nb * 8, lane);
    transpose8_items(p, 0, T8_W2_START + PREP_W2_ITEMS, bid * 8 + wave, nb * 8, lane);
}

__device__ __forceinline__ void norm_mod_row(const float* xrow, const float* g, const float* sc, const float* sh, bf16_t* orow, int lane) {
    f32x4 v[4]; float s = 0.f;
#pragma unroll
    for (int j = 0; j < 4; ++j) { v[j] = *(const f32x4*)(xrow + 4 * lane + 256 * j); s += (v[j].x * v[j].x + v[j].y * v[j].y) + (v[j].z * v[j].z + v[j].w * v[j].w); }
    const float rinv = 1.0f / sqrtf(wave_sum(s) * (1.f / DM) + EPS);
#pragma unroll
    for (int j = 0; j < 4; ++j) {
        const f32x4 gg = *(const f32x4*)(g + 4 * lane + 256 * j), cc = *(const f32x4*)(sc + 4 * lane + 256 * j), hh = *(const f32x4*)(sh + 4 * lane + 256 * j);
        const f32x4 o = v[j] * rinv * gg * (1.0f + cc) + hh;
        u32x2 w; w.x = pk2(o.x, o.y); w.y = pk2(o.z, o.w);
        *(u32x2*)(orow + 4 * lane + 256 * j) = w;
    }
}
__device__ __forceinline__ void phase_h1(const Params& p, int bid, int nb) {
    const int lane = threadIdx.x & 63, wave = threadIdx.x >> 6, gw = bid * 8 + wave, NGW = nb * 8;
    const float* mod = (const float*)(p.ws + WS_MOD);
    if (bid == nb - 1)
        for (int i = threadIdx.x; i < 2 * DM; i += 512) { const int b = i >> 10, k = i & 1023; ((float*)(p.ws + WS_GAM2))[i] = p.g_ffn[k] * (1.0f + mod[b * (NMOD * DM) + 4 * DM + k]); }
    for (int pr = gw; pr < 2 * NEXP; pr += NGW) {
        const int b = pr >> 5, e = pr & 31; const float* wr = (const float*)(p.ws + WS_WRT) + (size_t)e * DM; const float* sh = mod + b * (NMOD * DM) + 3 * DM; float a = 0.f;
#pragma unroll
        for (int j = 0; j < 4; ++j) { const f32x4 w = *(const f32x4*)(wr + 4 * lane + 256 * j), h = *(const f32x4*)(sh + 4 * lane + 256 * j); a += (w.x * h.x + w.y * h.y) + (w.z * h.z + w.w * h.w); }
        a = wave_sum(a); if (lane == 0) ((float*)(p.ws + WS_CB))[pr] = a + p.b_router[e]; }
    for (int m = gw; m < NTOK; m += NGW) { const int b = m / SEQ;
        norm_mod_row(p.x + (size_t)m * DM, p.g_mix, mod + b * (NMOD * DM) + 1 * DM, mod + b * (NMOD * DM) + 0 * DM, (bf16_t*)(p.ws + WS_H1) + (size_t)m * DM, lane); }
}

__device__ __forceinline__ void phase_combine(const Params& p, int bid, int nb) {
    const int lane = threadIdx.x & 63, wave = threadIdx.x >> 6, gw = bid * 8 + wave, NGW = nb * 8;
    const float lam = *(const float*)(p.ws + WS_LAM);
    const int h = lane >> 4, e0 = (lane & 15) * 8;
    float g[8];
#pragma unroll
    for (int i = 0; i < 8; ++i) g[i] = p.g_subln[e0 + i] * (1.0f - LAMBDA_INIT);
    for (int m0 = gw; m0 < NTOK; m0 += 4 * NGW) {
        u32x4 a[4], b[4];
#pragma unroll
        for (int q = 0; q < 4; ++q) { const int m = m0 + q * NGW; if (m < NTOK) { const bf16_t* ov = (const bf16_t*)(p.ws + WS_OV) + (size_t)m * DM;
            a[q] = *(const u32x4*)(ov + (h * 2 + 0) * 128 + e0); b[q] = *(const u32x4*)(ov + (h * 2 + 1) * 128 + e0); } }
#pragma unroll
        for (int q = 0; q < 4; ++q) { const int m = m0 + q * NGW; if (m < NTOK) {
            float o[8]; float s = 0.f;
#pragma unroll
            for (int i = 0; i < 4; ++i) { o[2 * i] = bflo(a[q][i]) - lam * bflo(b[q][i]); o[2 * i + 1] = bfhi(a[q][i]) - lam * bfhi(b[q][i]); }
#pragma unroll
            for (int i = 0; i < 8; ++i) s += o[i] * o[i];
            s += __shfl_xor(s, 1); s += __shfl_xor(s, 2); s += __shfl_xor(s, 4); s += __shfl_xor(s, 8);
            const float rinv = 1.0f / sqrtf(s * (1.f / 128.f) + EPS);
            u32x4 w; w.x = pk2(o[0] * rinv * g[0], o[1] * rinv * g[1]); w.y = pk2(o[2] * rinv * g[2], o[3] * rinv * g[3]);
            w.z = pk2(o[4] * rinv * g[4], o[5] * rinv * g[5]); w.w = pk2(o[6] * rinv * g[6], o[7] * rinv * g[7]);
            *(u32x4*)((bf16_t*)(p.ws + WS_MIXED) + (size_t)m * DM + 512 + h * 128 + e0) = w; } }
    }
}

typedef float f32x16 __attribute__((ext_vector_type(16)));
constexpr int RT_STG = 0, RT_P = 8 * 32 * 68 * 4, RT_RI = RT_P + 4 * 64 * 33 * 4, RT_HIST = RT_RI + 256, ROUTER_LDS = RT_HIST + 2048;
__device__ __forceinline__ void phase_router(const Params& p, int bid, int nb, unsigned char* ldsb) {
    const int tid = threadIdx.x, lane = tid & 63, wave = tid >> 6;
    float* P = (float*)(ldsb + RT_P); float* RI = (float*)(ldsb + RT_RI); int* hist = (int*)(ldsb + RT_HIST); int* gbase = hist + 32; int* rec = hist + 64;
    unsigned* cnt = (unsigned*)(p.ws + WS_CTL) + CW_CNT;
    const float* wrT = (const float*)(p.ws + WS_WRT); const float* mod = (const float*)(p.ws + WS_MOD); const float* X1 = (const float*)(p.ws + WS_X1);
    for (int r0 = bid * 64; r0 < NTOK; r0 += nb * 64) {
        const int b = r0 / SEQ; const float* gam = (const float*)(p.ws + WS_GAM2) + b * DM; const float* sh2 = mod + b * (NMOD * DM) + 3 * DM; const float* cb = (const float*)(p.ws + WS_CB) + b * NEXP;
        if (tid < 32) hist[tid] = 0;
        if (tid < 64) { const f32x4* ps = (const f32x4*)((const float*)(p.ws + WS_PSUM) + (size_t)(r0 + tid) * 16); const f32x4 a = ps[0], c = ps[1], d = ps[2], e = ps[3];
            const float ssum = (((a.x + a.y) + (a.z + a.w)) + ((c.x + c.y) + (c.z + c.w))) + (((d.x + d.y) + (d.z + d.w)) + ((e.x + e.y) + (e.z + e.w)));
            RI[tid] = 1.0f / sqrtf(ssum * (1.f / DM) + EPS); }
        __syncthreads();
        { const int rg = wave >> 2, kq = wave & 3, rr = lane & 31, hh = lane >> 5, lr = lane >> 4, lc = 4 * (lane & 15);
            float* stg = (float*)(ldsb + RT_STG) + wave * (32 * 68);
            const float* wr = wrT + (size_t)rr * DM + 4 * hh;
            f32x16 acc;
#pragma unroll
            for (int r = 0; r < 16; ++r) acc[r] = 0.f;
#pragma unroll 1
            for (int ch = 0; ch < 4; ++ch) { const int kb = kq * 256 + ch * 64;
                f32x4 xv[8];
#pragma unroll
                for (int j = 0; j < 8; ++j) xv[j] = *(const f32x4*)(X1 + (size_t)(r0 + rg * 32 + 4 * j + lr) * DM + kb + lc);
                const f32x4 gv = *(const f32x4*)(gam + kb + lc), bv = *(const f32x4*)(sh2 + kb + lc);
#pragma unroll
                for (int j = 0; j < 8; ++j) { const int row = 4 * j + lr; const f32x4 a = xv[j] * gv, h = a * RI[rg * 32 + row] + bv;
                    *(unsigned*)(p.ws + WS_H2 + (size_t)(r0 + rg * 32 + row) * DM + kb + lc) = pk4_fp8(h.x, h.y, h.z, h.w);
                    *(f32x4*)(stg + row * 68 + lc) = a; }
#pragma unroll
                for (int i = 0; i < 8; ++i) { const f32x4 av = *(const f32x4*)(stg + rr * 68 + 8 * i + 4 * hh), wv = *(const f32x4*)(wr + kb + 8 * i);
                    acc = __builtin_amdgcn_mfma_f32_32x32x2f32(av.x, wv.x, acc, 0, 0, 0); acc = __builtin_amdgcn_mfma_f32_32x32x2f32(av.y, wv.y, acc, 0, 0, 0);
                    acc = __builtin_amdgcn_mfma_f32_32x32x2f32(av.z, wv.z, acc, 0, 0, 0); acc = __builtin_amdgcn_mfma_f32_32x32x2f32(av.w, wv.w, acc, 0, 0, 0); }
            }
#pragma unroll
            for (int r = 0; r < 16; ++r) P[(kq * 64 + rg * 32 + (r & 3) + 8 * (r >> 2) + 4 * hh) * 33 + rr] = acc[r];
        }
        __syncthreads();
        if (wave == 0) { const int m = r0 + lane; const float rinv = RI[lane];
            float tv[4] = {-INFINITY, -INFINITY, -INFINITY, -INFINITY}; int ti[4] = {0, 0, 0, 0};
#pragma unroll
            for (int e = 0; e < 32; ++e) { const float val = rinv * ((P[lane * 33 + e] + P[(64 + lane) * 33 + e]) + (P[(128 + lane) * 33 + e] + P[(192 + lane) * 33 + e])) + cb[e];
                if (val > tv[3]) { tv[3] = val; ti[3] = e;
                    if (tv[3] > tv[2]) { float t = tv[2]; tv[2] = tv[3]; tv[3] = t; int q = ti[2]; ti[2] = ti[3]; ti[3] = q;
                        if (tv[2] > tv[1]) { t = tv[1]; tv[1] = tv[2]; tv[2] = t; q = ti[1]; ti[1] = ti[2]; ti[2] = q;
                            if (tv[1] > tv[0]) { t = tv[0]; tv[0] = tv[1]; tv[1] = t; q = ti[0]; ti[0] = ti[1]; ti[1] = q; } } } } }
            const float e1 = __expf(tv[1] - tv[0]), e2 = __expf(tv[2] - tv[0]), e3 = __expf(tv[3] - tv[0]); const float inv = 1.0f / (1.0f + e1 + e2 + e3);
            f32x4 gt; gt.x = inv; gt.y = e1 * inv; gt.z = e2 * inv; gt.w = e3 * inv;
            *(f32x4*)((float*)(p.ws + WS_GATE) + (size_t)m * 4) = gt;
#pragma unroll
            for (int k = 0; k < 4; ++k) { const int lp = atomicAdd(&hist[ti[k]], 1); rec[lane * 4 + k] = (ti[k] << 16) | lp; }
        }
        __syncthreads();
        if (tid < 32) gbase[tid] = (int)atomicAdd(&cnt[tid], (unsigned)hist[tid]);
        __syncthreads();
        if (tid < 256) { const int lrow = tid >> 2, k = tid & 3, m = r0 + lrow; const int rc = rec[lrow * 4 + k], e = rc >> 16, pos = gbase[e] + (rc & 0xffff);
            ((int*)(p.ws + WS_LIST))[e * NTOK + pos] = m; ((int*)(p.ws + WS_TOKPOS))[(size_t)m * 4 + k] = e * NTOK + pos; }
        __syncthreads();
    }
}

__device__ __forceinline__ void phase_final(const Params& p, int bid, int nb) {
    const int lane = threadIdx.x & 63, wave = threadIdx.x >> 6, gw = bid * 8 + wave, NGW = nb * 8;
    const unsigned* cnt = (const unsigned*)(p.ws + WS_CTL) + CW_CNT;
    int mybase = 0; { int acc = 0; for (int e = 0; e < 32; ++e) { if (e == (lane & 31)) mybase = acc; acc += (int)((cnt[e] + 255u) >> 8) * 256; } }
    const float* mod = (const float*)(p.ws + WS_MOD);
    for (int m = gw; m < NTOK; m += NGW) {
        const int b = m / SEQ; const float* gt2 = mod + b * (NMOD * DM) + 5 * DM;
        const float* xrow = (const float*)(p.ws + WS_X1) + (size_t)m * DM;
        f32x4 acc[4];
#pragma unroll
        for (int j = 0; j < 4; ++j) acc[j] = (f32x4){0.f, 0.f, 0.f, 0.f};
#pragma unroll
        for (int k = 0; k < 4; ++k) {
            const int tp = ((const int*)(p.ws + WS_TOKPOS))[(size_t)m * 4 + k]; const float gk = ((const float*)(p.ws + WS_GATE))[(size_t)m * 4 + k];
            const int e = tp / NTOK, pos = tp % NTOK; const int row = __shfl(mybase, e) + pos;
            const bf16_t* yr = (const bf16_t*)(p.ws + WS_Y) + (size_t)row * DM;
#pragma unroll
            for (int j = 0; j < 4; ++j) { const u32x2 w = *(const u32x2*)(yr + 4 * lane + 256 * j);
                acc[j].x += gk * bflo(w.x); acc[j].y += gk * bfhi(w.x); acc[j].z += gk * bflo(w.y); acc[j].w += gk * bfhi(w.y); }
        }
        float s = 0.f;
#pragma unroll
        for (int j = 0; j < 4; ++j) { const f32x4 xv = *(const f32x4*)(xrow + 4 * lane + 256 * j), gg = *(const f32x4*)(gt2 + 4 * lane + 256 * j);
            acc[j] = xv + gg * acc[j]; s += (acc[j].x * acc[j].x + acc[j].y * acc[j].y) + (acc[j].z * acc[j].z + acc[j].w * acc[j].w); }
        const float rinv = 1.0f / sqrtf(wave_sum(s) * (1.f / DM) + EPS);
#pragma unroll
        for (int j = 0; j < 4; ++j) { const f32x4 gf = *(const f32x4*)(p.g_final + 4 * lane + 256 * j);
            *(f32x4*)(p.out + (size_t)m * DM + 4 * lane + 256 * j) = acc[j] * rinv * gf; }
    }
}

namespace pg8 {
#define PG8_LAS __attribute__((address_space(3)))
constexpr int BM = 256, BK = 64, HALF = 128, HTB = HALF * BK * 2  , STAGE_BYTES = 8 * HTB, NXCD = 8, WGM = 8;

__host__ __device__ __forceinline__ int lds_byte(int r, int c) { const int st = (r >> 4) * 2 + (c >> 5), rr = r & 15, cc = c & 31, ob = rr * 64 + cc * 2; return st * 1024 + (ob ^ (((ob >> 9) & 1) << 5)); }
__host__ __device__ __forceinline__ void stage_rc(int b, int& R, int& C) { const int st = b / 1024, sb = b % 1024, swz = sb ^ (((sb >> 9) & 1) << 5); R = (st >> 1) * 16 + swz / 64; C = (st & 1) * 32 + (swz % 64) / 2; }
__host__ __device__ __forceinline__ int perm32(int rho) { const int n = rho >> 4, i = rho & 15; return 8 * (i >> 2) + 4 * n + (i & 3); }

struct Unit { int pm, pn, e, mt; };
struct Gemm { const void* A; const void* Bt; int RB; size_t bstride; };
typedef int i32x4 __attribute__((ext_vector_type(4))); typedef int i32x8 __attribute__((ext_vector_type(8)));

__host__ __device__ __forceinline__ int xcd_remap(int wgid, int nwg) { const int q = nwg / NXCD, r = nwg % NXCD, xcd = wgid % NXCD, off = wgid / NXCD; return (xcd < r ? xcd * (q + 1) : r * (q + 1) + (xcd - r) * q) + off; }

struct StaticOrder {
    int nM, nN, nwg, G, c;
    __device__ void init(int M, int N, int G_, int c_) { nM = M / BM; nN = N / BM; nwg = nM * nN; G = G_; c = c_; }
    __device__ bool next(int i, Unit& u) const {
        const long L = (long)i * G + c; if (L >= nwg) return false;
        const int wgid = xcd_remap((int)L, nwg);
        const int nig = WGM * nN, gid = wgid / nig, fm = gid * WGM, gsz = (nM - fm) < WGM ? (nM - fm) : WGM;
        u.pm = fm + ((wgid % nig) % gsz); u.pn = (wgid % nig) / gsz; u.e = 0; u.mt = 0; return true;
    }
    __device__ __forceinline__ int row(const Unit& u, int r) const { return u.pm * BM + r; }
};
struct GroupedOrder {
    const PG8_LAS int* tb; const PG8_LAS int* cnt; const int* list; int nN, nwg, G, c;
    __device__ void init(const PG8_LAS int* tb_, const PG8_LAS int* cnt_, const int* list_, int nN_, int G_, int c_) { tb = tb_; cnt = cnt_; list = list_; nN = nN_; nwg = tb_[32] * nN_; G = G_; c = c_; }
    __device__ bool next(int i, Unit& u) const {
        const long L = (long)i * G + c; if (L >= nwg) return false;
        const int wgid = xcd_remap((int)L, nwg);
        const int t = wgid / nN; int e = 0; while (t >= tb[e + 1]) ++e;
        u.pm = t; u.pn = wgid % nN; u.e = e; u.mt = t - tb[e]; return true;
    }
    __device__ __forceinline__ int row(const Unit& u, int r) const { const int pos = u.mt * BM + r; return pos < cnt[u.e] ? list[u.e * NTOK + pos] : 0; }
};

__device__ __forceinline__ unsigned cvt_pk_bf16(float lo, float hi) { unsigned r; asm volatile("v_cvt_pk_bf16_f32 %0, %1, %2" : "=v"(r) : "v"(lo), "v"(hi)); return r; }

struct EpiProj {
    static constexpr bool PERM = true;
    bf16_t* O; const float* bias; const float* ropec; const float* ropes;
    __device__ __forceinline__ void operator()(const f32x4 (&acc)[2][2][4][2], const Unit& u, int wr, int wc, int fr, int fq) const {
        const int row0 = u.pm * BM + wr * 64 + fr, colb = u.pn * BM + wc * 32 + 8 * fq, f0 = ((wc * 32 + 8 * fq) & 63) >> 1;
        f32x4 bv[2][2];
#pragma unroll
        for (int bj = 0; bj < 2; ++bj)
#pragma unroll
            for (int n = 0; n < 2; ++n) bv[bj][n] = *(const f32x4*)(bias + colb + bj * HALF + 4 * n);
#pragma unroll
        for (int ai = 0; ai < 2; ++ai)
#pragma unroll
            for (int m = 0; m < 4; ++m) { const int row = row0 + ai * HALF + m * 16;
                const f32x4 cs = *(const f32x4*)(ropec + (size_t)row * 32 + f0), sn = *(const f32x4*)(ropes + (size_t)row * 32 + f0);
                bf16_t* rowp = O + (size_t)row * NPROJ + colb;
#pragma unroll
                for (int bj = 0; bj < 2; ++bj) { const int hidx = u.pn * 2 + bj;
                    f32x4 v0 = acc[ai][bj][m][0] + bv[bj][0], v1 = acc[ai][bj][m][1] + bv[bj][1];
                    if (hidx < PC_ROPE_END / HALF) {
                        f32x4 w0, w1;
                        w0[0] = v0[0] * cs[0] - v0[1] * sn[0]; w0[1] = v0[1] * cs[0] + v0[0] * sn[0]; w0[2] = v0[2] * cs[1] - v0[3] * sn[1]; w0[3] = v0[3] * cs[1] + v0[2] * sn[1];
                        w1[0] = v1[0] * cs[2] - v1[1] * sn[2]; w1[1] = v1[1] * cs[2] + v1[0] * sn[2]; w1[2] = v1[2] * cs[3] - v1[3] * sn[3]; w1[3] = v1[3] * cs[3] + v1[2] * sn[3];
                        const float sc = (hidx < PC_KA / HALF || (hidx >= PC_QD / HALF && hidx < PC_KD / HALF)) ? C2 : 1.0f;
                        v0 = w0 * sc; v1 = w1 * sc; }
                    u32x4 w; w.x = cvt_pk_bf16(v0[0], v0[1]); w.y = cvt_pk_bf16(v0[2], v0[3]); w.z = cvt_pk_bf16(v1[0], v1[1]); w.w = cvt_pk_bf16(v1[2], v1[3]);
                    *(u32x4*)(rowp + bj * HALF) = w; } }
    }
};
struct EpiX1 {
    static constexpr bool PERM = false;
    const float* x; const float* mod; const float* bias; float* out; float* psum;
    __device__ __forceinline__ void operator()(const f32x4 (&acc)[2][2][4][2], const Unit& u, int wr, int wc, int fr, int fq) const {
        const int row0 = u.pm * BM + wr * 64 + fr, col0 = u.pn * BM + wc * 32 + 4 * fq; const float* gt = mod + ((u.pm * BM) / SEQ) * (NMOD * DM) + 2 * DM;
        f32x4 bv[2][2], gv[2][2];
#pragma unroll
        for (int bj = 0; bj < 2; ++bj)
#pragma unroll
            for (int n = 0; n < 2; ++n) { const int c = col0 + bj * HALF + n * 16; bv[bj][n] = *(const f32x4*)(bias + c); gv[bj][n] = *(const f32x4*)(gt + c); }
#pragma unroll
        for (int ai = 0; ai < 2; ++ai)
#pragma unroll
            for (int m = 0; m < 4; ++m) { const int row = row0 + ai * HALF + m * 16; float ss = 0.f;
#pragma unroll
                for (int bj = 0; bj < 2; ++bj)
#pragma unroll
                    for (int n = 0; n < 2; ++n) { const size_t off = (size_t)row * DM + col0 + bj * HALF + n * 16;
                        const f32x4 v = *(const f32x4*)(x + off) + gv[bj][n] * (acc[ai][bj][m][n] + bv[bj][n]);
                        *(f32x4*)(out + off) = v; ss += (v.x * v.x + v.y * v.y) + (v.z * v.z + v.w * v.w); }
                ss += __shfl_xor(ss, 16); ss += __shfl_xor(ss, 32);
                if (fq == 0) psum[(size_t)row * 16 + u.pn * 4 + wc] = ss; }
    }
};
__device__ __forceinline__ float swiglu1(float g, float l) { g = fminf(g, 7.0f); l = fminf(fmaxf(l, -7.0f), 7.0f); return g * __builtin_amdgcn_rcpf(1.0f + __builtin_amdgcn_exp2f(-1.702f * LOG2E * g)) * (l + 1.0f); }
struct EpiSwiglu {
    static constexpr bool PERM = true;
    const float* b1; unsigned char* act;
    __device__ __forceinline__ void operator()(const f32x4 (&acc)[2][2][4][2], const Unit& u, int wr, int wc, int fr, int fq) const {
        const int row0 = u.pm * BM + wr * 64 + fr, colb = u.pn * BM + wc * 32 + 8 * fq; const float* bias = b1 + (size_t)u.e * (2 * DFF);
        f32x4 bv[2][2];
#pragma unroll
        for (int bj = 0; bj < 2; ++bj)
#pragma unroll
            for (int n = 0; n < 2; ++n) bv[bj][n] = *(const f32x4*)(bias + colb + bj * HALF + 4 * n);
#pragma unroll
        for (int ai = 0; ai < 2; ++ai)
#pragma unroll
            for (int m = 0; m < 4; ++m) { unsigned char* rowp = act + (size_t)(row0 + ai * HALF + m * 16) * DFF + (colb >> 1);
#pragma unroll
                for (int bj = 0; bj < 2; ++bj) { const f32x4 v0 = acc[ai][bj][m][0] * (1.0f / W8_SCALE) + bv[bj][0], v1 = acc[ai][bj][m][1] * (1.0f / W8_SCALE) + bv[bj][1];
                    *(unsigned*)(rowp + bj * (HALF / 2)) = pk4_fp8(swiglu1(v0[0], v0[1]), swiglu1(v0[2], v0[3]), swiglu1(v1[0], v1[1]), swiglu1(v1[2], v1[3])); } }
    }
};
struct EpiY {
    static constexpr bool PERM = true;
    const float* b2; bf16_t* y;
    __device__ __forceinline__ void operator()(const f32x4 (&acc)[2][2][4][2], const Unit& u, int wr, int wc, int fr, int fq) const {
        const int row0 = u.pm * BM + wr * 64 + fr, colb = u.pn * BM + wc * 32 + 8 * fq; const float* bias = b2 + (size_t)u.e * DM;
        f32x4 bv[2][2];
#pragma unroll
        for (int bj = 0; bj < 2; ++bj)
#pragma unroll
            for (int n = 0; n < 2; ++n) bv[bj][n] = *(const f32x4*)(bias + colb + bj * HALF + 4 * n);
#pragma unroll
        for (int ai = 0; ai < 2; ++ai)
#pragma unroll
            for (int m = 0; m < 4; ++m) { bf16_t* rowp = y + (size_t)(row0 + ai * HALF + m * 16) * DM + colb;
#pragma unroll
                for (int bj = 0; bj < 2; ++bj) { const f32x4 v0 = acc[ai][bj][m][0] * (1.0f / W8_SCALE) + bv[bj][0], v1 = acc[ai][bj][m][1] * (1.0f / W8_SCALE) + bv[bj][1];
                    u32x4 w; w.x = cvt_pk_bf16(v0[0], v0[1]); w.y = cvt_pk_bf16(v0[2], v0[3]); w.z = cvt_pk_bf16(v1[0], v1[1]); w.w = cvt_pk_bf16(v1[2], v1[3]);
                    *(u32x4*)(rowp + bj * HALF) = w; } }
    }
};

template <class Epi, class Sched, bool GATHER, bool F8>
__device__ __forceinline__ void gemm_phase(PG8_LAS unsigned char* lds, const Gemm g, const Sched& S, const Epi& E) {
    const int tid = threadIdx.x, wid = __builtin_amdgcn_readfirstlane(tid >> 6), lane = tid & 63, wr = wid >> 2, wc = wid & 3, fr = lane & 15, fq = lane >> 4;
    const int RB = g.RB, nt = RB / (BK * 2);
    unsigned voffA[2], voffB[2]; int RA[2], CA[2];
#pragma unroll
    for (int i = 0; i < 2; ++i) { int R, C; stage_rc(tid * 16 + i * 8192, R, C); const int Rb = Epi::PERM ? ((R & ~31) + perm32(R & 31)) : R;
        voffA[i] = (unsigned)(R * RB + C * 2); voffB[i] = (unsigned)(Rb * RB + C * 2); RA[i] = R; CA[i] = C; }
    const size_t kstep = (size_t)(BK * 2);
    const size_t hstep = (size_t)HALF * RB;
    const size_t tstep = 2 * hstep;
    const unsigned ldsw = (unsigned)wid * 1024u;
    const int aoff = lds_byte(wr * 64 + fr, fq * 8), boff = lds_byte(wc * 32 + fr, fq * 8);
    const int aoff0 = lds_byte(wr * 64 + fr, fq * 16), boff0 = lds_byte(wc * 32 + fr, fq * 16);
    const char* gA = (const char*)g.A;
#define PG8_SA(b, h) (((b) * 2 + (h)) * HTB)
#define PG8_SB(b, h) ((4 + (b) * 2 + (h)) * HTB)
#define PG8_STAGE(bufoff, gbase, voff) do { _Pragma("unroll") for (int _i = 0; _i < 2; ++_i) \
        __builtin_amdgcn_global_load_lds((const unsigned*)((const char*)(gbase) + (voff)[_i]), (PG8_LAS unsigned*)(lds + (bufoff) + ldsw + _i * 8192), 16, 0, 0); } while (0)
#define PG8_STAGE_A(bufoff, dptr, kb, go) do { _Pragma("unroll") for (int _i = 0; _i < 2; ++_i) { \
        const char* _s = GATHER ? (gA + (kb) + (go)[_i]) : ((const char*)(dptr) + voffA[_i]); \
        __builtin_amdgcn_global_load_lds((const unsigned*)_s, (PG8_LAS unsigned*)(lds + (bufoff) + ldsw + _i * 8192), 16, 0, 0); } } while (0)
#define PG8_LDA(dst, b, h) do { _Pragma("unroll") for (int m = 0; m < 4; ++m) _Pragma("unroll") for (int k = 0; k < 2; ++k) dst[m][k] = *(const PG8_LAS bf16x8*)(lds + PG8_SA(b, h) + aoff + m * 2048 + k * 1024); } while (0)
#define PG8_LDB(dst, b, h) do { _Pragma("unroll") for (int n = 0; n < 2; ++n) _Pragma("unroll") for (int k = 0; k < 2; ++k) dst[n][k] = *(const PG8_LAS bf16x8*)(lds + PG8_SB(b, h) + boff + n * 2048 + k * 1024); } while (0)
#define PG8_MMA(ai, bj, At, Bt) do { __builtin_amdgcn_s_setprio(1); _Pragma("unroll") for (int m = 0; m < 4; ++m) _Pragma("unroll") for (int n = 0; n < 2; ++n) _Pragma("unroll") for (int k = 0; k < 2; ++k) \
        acc[ai][bj][m][n] = __builtin_amdgcn_mfma_f32_16x16x32_bf16(Bt[n][k], At[m][k], acc[ai][bj][m][n], 0, 0, 0); __builtin_amdgcn_s_setprio(0); } while (0)
#define PG8_LDA8(dst, b, h) do { _Pragma("unroll") for (int m = 0; m < 4; ++m) { const i32x4 lo_ = *(const PG8_LAS i32x4*)(lds + PG8_SA(b, h) + aoff0 + m * 2048), hi_ = *(const PG8_LAS i32x4*)(lds + PG8_SA(b, h) + aoff0 + 16 + m * 2048); \
        dst[m] = __builtin_shufflevector(lo_, hi_, 0, 1, 2, 3, 4, 5, 6, 7); } } while (0)
#define PG8_LDB8(dst, b, h) do { _Pragma("unroll") for (int n = 0; n < 2; ++n) { const i32x4 lo_ = *(const PG8_LAS i32x4*)(lds + PG8_SB(b, h) + boff0 + n * 2048), hi_ = *(const PG8_LAS i32x4*)(lds + PG8_SB(b, h) + boff0 + 16 + n * 2048); \
        dst[n] = __builtin_shufflevector(lo_, hi_, 0, 1, 2, 3, 4, 5, 6, 7); } } while (0)
#define PG8_MMA8(ai, bj, At, Bt) do { __builtin_amdgcn_s_setprio(1); _Pragma("unroll") for (int m = 0; m < 4; ++m) _Pragma("unroll") for (int n = 0; n < 2; ++n) \
        asm volatile("v_mfma_scale_f32_16x16x128_f8f6f4 %0, %1, %2, %0, %3, %3 op_sel_hi:[0,0,0]" : "+v"(acc[ai][bj][m][n]) : "v"(Bt[n]), "v"(At[m]), "v"(sc8)); __builtin_amdgcn_s_setprio(0); } while (0)
#define PG8_WAIT_V(n) asm volatile("s_waitcnt vmcnt(" #n ")" ::: "memory")
#define PG8_WAIT_L(n) asm volatile("s_waitcnt lgkmcnt(" #n ")" ::: "memory")
#define PG8_BAR __builtin_amdgcn_s_barrier()
#define PG8_SCHED __builtin_amdgcn_sched_barrier(0)
#define PG8_GOFFS(dst, un) do { if (GATHER) { _Pragma("unroll") for (int _h = 0; _h < 2; ++_h) _Pragma("unroll") for (int _i = 0; _i < 2; ++_i) \
        dst[_h][_i] = (unsigned)S.row(un, _h * HALF + RA[_i]) * (unsigned)RB + (unsigned)(CA[_i] * 2); } } while (0)
    Unit cur, nxt; int ui = 0;
    if (!S.next(0, cur)) return;
    f32x4 acc[2][2][4][2];
#pragma unroll
    for (int a = 0; a < 2; ++a)
#pragma unroll
        for (int b = 0; b < 2; ++b)
#pragma unroll
            for (int m = 0; m < 4; ++m)
#pragma unroll
                for (int n = 0; n < 2; ++n) acc[a][b][m][n] = (f32x4){0.f, 0.f, 0.f, 0.f};
    const int sc8 = 0x7f7f7f7f;
    bf16x8 At[4][2], B0[2][2], B1[2][2]; i32x8 At8[4], B08[2], B18[2];
    unsigned gcur[2][2] = {{0u, 0u}, {0u, 0u}}, gnxt[2][2] = {{0u, 0u}, {0u, 0u}};
    PG8_GOFFS(gcur, cur);
    const char* cA = gA + (GATHER ? (size_t)0 : (size_t)cur.pm * tstep); const char* cB = (const char*)g.Bt + (size_t)cur.e * g.bstride + (size_t)cur.pn * tstep;
    PG8_STAGE(PG8_SB(0, 0), cB, voffB); PG8_STAGE(PG8_SB(0, 1), cB + hstep, voffB); PG8_STAGE_A(PG8_SA(0, 0), cA, (size_t)0, gcur[0]); PG8_STAGE_A(PG8_SA(0, 1), cA + hstep, (size_t)0, gcur[1]);
    if (wr == 1) PG8_BAR;
    PG8_WAIT_V(2); PG8_BAR;
    PG8_STAGE(PG8_SB(1, 0), cB + kstep, voffB); PG8_STAGE_A(PG8_SA(1, 0), cA + kstep, kstep, gcur[0]); PG8_STAGE(PG8_SB(1, 1), cB + hstep + kstep, voffB);
    PG8_WAIT_V(6); PG8_BAR;
    for (;;) {
        const bool has_next = S.next(ui + 1, nxt);
        if (has_next) PG8_GOFFS(gnxt, nxt);
        const char* nA = (has_next && !GATHER) ? gA + (size_t)nxt.pm * tstep : cA; const char* nB = has_next ? (const char*)g.Bt + (size_t)nxt.e * g.bstride + (size_t)nxt.pn * tstep : cB;
#pragma unroll 1
        for (int t = 0; t < nt; t += 2) {
            const bool last = (t == nt - 2);
            const char* a1 = cA + (size_t)(t + 1) * kstep;
            const char* a2 = last ? nA : cA + (size_t)(t + 2) * kstep; const char* b2 = last ? nB : cB + (size_t)(t + 2) * kstep;
            const char* a3 = a2 + kstep; const char* b3 = b2 + kstep;
            const size_t k1 = (size_t)(t + 1) * kstep, k2 = last ? (size_t)0 : (size_t)(t + 2) * kstep, k3 = k2 + kstep;
            unsigned gsel[2][2];
#pragma unroll
            for (int h = 0; h < 2; ++h)
#pragma unroll
                for (int i = 0; i < 2; ++i) gsel[h][i] = (last && has_next) ? gnxt[h][i] : gcur[h][i];
#define PG8_RB(b) do { if (F8) { PG8_LDB8(B08, b, 0); PG8_LDB8(B18, b, 1); } else { PG8_LDB(B0, b, 0); PG8_LDB(B1, b, 1); } } while (0)
#define PG8_RA(b, h) do { if (F8) PG8_LDA8(At8, b, h); else PG8_LDA(At, b, h); } while (0)
#define PG8_MM(ai) do { if (F8) { PG8_MMA8(ai, 0, At8, B08); PG8_MMA8(ai, 1, At8, B18); } else { PG8_MMA(ai, 0, At, B0); PG8_MMA(ai, 1, At, B1); } } while (0)
            PG8_RB(0); PG8_SCHED; PG8_RA(0, 0); PG8_STAGE_A(PG8_SA(1, 1), a1 + hstep, k1, gcur[1]);
            PG8_WAIT_V(8); PG8_WAIT_L(0); PG8_BAR; PG8_MM(0); PG8_BAR; PG8_SCHED;
            PG8_RA(0, 1); PG8_STAGE(PG8_SB(0, 0), b2, voffB); PG8_STAGE(PG8_SB(0, 1), b2 + hstep, voffB); PG8_STAGE_A(PG8_SA(0, 0), a2, k2, gsel[0]);
            PG8_WAIT_V(8); PG8_WAIT_L(0); PG8_BAR; PG8_MM(1); PG8_BAR; PG8_SCHED;
            PG8_RB(1); PG8_SCHED; PG8_RA(1, 0); PG8_STAGE_A(PG8_SA(0, 1), a2 + hstep, k2, gsel[1]);
            PG8_WAIT_V(8); PG8_WAIT_L(0); PG8_BAR; PG8_MM(0); PG8_BAR; PG8_SCHED;
            PG8_RA(1, 1); PG8_STAGE(PG8_SB(1, 0), b3, voffB); PG8_STAGE(PG8_SB(1, 1), b3 + hstep, voffB); PG8_STAGE_A(PG8_SA(1, 0), a3, k3, gsel[0]);
            PG8_WAIT_V(8); PG8_WAIT_L(0); PG8_BAR; PG8_MM(1); PG8_BAR; PG8_SCHED;
        }
        if (F8) {
            asm volatile("s_nop 15\n\ts_nop 15" : "+v"(acc[0][0][0][0]), "+v"(acc[0][0][0][1]), "+v"(acc[0][0][1][0]), "+v"(acc[0][0][1][1]), "+v"(acc[0][0][2][0]), "+v"(acc[0][0][2][1]), "+v"(acc[0][0][3][0]), "+v"(acc[0][0][3][1]), "+v"(acc[0][1][0][0]), "+v"(acc[0][1][0][1]), "+v"(acc[0][1][1][0]), "+v"(acc[0][1][1][1]), "+v"(acc[0][1][2][0]), "+v"(acc[0][1][2][1]), "+v"(acc[0][1][3][0]), "+v"(acc[0][1][3][1]));
            asm volatile("s_nop 15\n\ts_nop 15" : "+v"(acc[1][0][0][0]), "+v"(acc[1][0][0][1]), "+v"(acc[1][0][1][0]), "+v"(acc[1][0][1][1]), "+v"(acc[1][0][2][0]), "+v"(acc[1][0][2][1]), "+v"(acc[1][0][3][0]), "+v"(acc[1][0][3][1]), "+v"(acc[1][1][0][0]), "+v"(acc[1][1][0][1]), "+v"(acc[1][1][1][0]), "+v"(acc[1][1][1][1]), "+v"(acc[1][1][2][0]), "+v"(acc[1][1][2][1]), "+v"(acc[1][1][3][0]), "+v"(acc[1][1][3][1])); }
        if (wr == 0) PG8_BAR;
        E(acc, cur, wr, wc, fr, fq);
        if (!has_next) break;
#pragma unroll
        for (int a = 0; a < 2; ++a)
#pragma unroll
            for (int b = 0; b < 2; ++b)
#pragma unroll
                for (int m = 0; m < 4; ++m)
#pragma unroll
                    for (int n = 0; n < 2; ++n) acc[a][b][m][n] = (f32x4){0.f, 0.f, 0.f, 0.f};
        cur = nxt; cA = nA; cB = nB; ++ui;
#pragma unroll
        for (int h = 0; h < 2; ++h)
#pragma unroll
            for (int i = 0; i < 2; ++i) gcur[h][i] = gnxt[h][i];
        if (wr == 1) PG8_BAR;
    }
    PG8_WAIT_V(0);
    PG8_BAR;
#undef PG8_SA
#undef PG8_SB
#undef PG8_STAGE
#undef PG8_STAGE_A
#undef PG8_LDA
#undef PG8_LDB
#undef PG8_MMA
#undef PG8_WAIT_V
#undef PG8_WAIT_L
#undef PG8_BAR
#undef PG8_SCHED
#undef PG8_GOFFS
#undef PG8_RB
#undef PG8_RA
#undef PG8_MM
#undef PG8_LDA8
#undef PG8_LDB8
#undef PG8_MMA8
}
}
namespace attn_body {
using bf16=unsigned short;
using bf16x8=__attribute__((ext_vector_type(8)))short;
using s16x4=__attribute__((ext_vector_type(4)))short;
using f32x16=::f32x16;
using u32x4=__attribute__((ext_vector_type(4)))unsigned;
constexpr int D=64,DM=2304;
constexpr int NW=8,QBLK=32,QB=QBLK*NW,KVBLK=64;
__device__ __forceinline__ int crow(int r,int hi){return (r&3)+8*(r>>2)+4*hi;}
#define SBAR() __builtin_amdgcn_sched_barrier(0)
__device__ __forceinline__ void cmask(f32x16&p0,f32x16&p1,int jb,int qrel,int hi){
  const float NEG=-INFINITY; int kb=64*jb+4*hi;
  #pragma unroll
  for(int r=0;r<16;++r){int kv=kb+(r&3)+8*(r>>2); if(kv>qrel)p0[r]=NEG; if(kv+32>qrel)p1[r]=NEG;}
}

__device__ __forceinline__ void smask(f32x16&p0,f32x16&p1,int t,int qrel,int hi,int shift){
  const float NEG=-INFINITY; int kb=64*t-shift+4*hi;
  #pragma unroll
  for(int r=0;r<16;++r){int kv=kb+(r&3)+8*(r>>2); if(kv>qrel||kv<=qrel-128)p0[r]=NEG; if(kv+32>qrel||kv+32<=qrel-128)p1[r]=NEG;}
}
constexpr int NSLOT=3, SLOTB=8192;
constexpr int LDS_K=0, LDS_V=NSLOT*SLOTB, LDS_WS=2*NSLOT*SLOTB, LDS_OST=LDS_WS+NW*64*4, LDS_BYTES=LDS_OST+NW*4096;
__device__ __forceinline__ void glds16(const void*gsrc,unsigned lds_dst){unsigned keep;
  asm volatile("s_mov_b32 %0, m0\n\ts_mov_b32 m0, %2\n\ts_nop 0\n\tglobal_load_lds_dwordx4 %1, off\n\ts_mov_b32 m0, %0":"=&s"(keep):"v"(gsrc),"s"(lds_dst):"memory");}
__device__ __forceinline__ float max3f(float a,float b,float c){float r;asm("v_max3_f32 %0, %1, %2, %3":"=v"(r):"v"(a),"v"(b),"v"(c));return r;}
__device__ __forceinline__ float max2f(float a,float b){float r;asm("v_max_f32_e32 %0, %1, %2":"=v"(r):"v"(a),"v"(b));return r;}
__device__ __forceinline__ float fadd_s(float a,float b){float r;asm("v_add_f32_e32 %0, %1, %2":"=v"(r):"v"(a),"v"(b));return r;}
__device__ __forceinline__ float fsub_s(float a,float b){float r;asm("v_sub_f32_e32 %0, %1, %2":"=v"(r):"v"(a),"v"(b));return r;}
typedef float f32x2_t __attribute__((ext_vector_type(2))); typedef __bf16 bf16x2_t __attribute__((ext_vector_type(2)));
__device__ __forceinline__ unsigned cvtpk_s(float lo,float hi){f32x2_t v={lo,hi};bf16x2_t b=__builtin_convertvector(v,bf16x2_t);return __builtin_bit_cast(unsigned,b);}
#define WAIT_BAR(N) asm volatile("s_waitcnt vmcnt(" #N ") lgkmcnt(0)\n\ts_barrier":::"memory")

__device__ __forceinline__ void qkt(f32x16&p0,f32x16&p1,const char*Kslot,const bf16x8*qr,const f32x16&negm,int r32,int hi){
  const char*kb=Kslot+hi*1024+r32*16;
  #pragma unroll
  for(int d0=0;d0<4;++d0){
    const bf16x8 b0=*reinterpret_cast<const bf16x8*>(kb+d0*2048);
    const bf16x8 b1=*reinterpret_cast<const bf16x8*>(kb+d0*2048+512);
    if(d0==0){p0=__builtin_amdgcn_mfma_f32_32x32x16_bf16(b0,qr[0],negm,0,0,0);p1=__builtin_amdgcn_mfma_f32_32x32x16_bf16(b1,qr[0],negm,0,0,0);}
    else{p0=__builtin_amdgcn_mfma_f32_32x32x16_bf16(b0,qr[d0],p0,0,0,0);p1=__builtin_amdgcn_mfma_f32_32x32x16_bf16(b1,qr[d0],p1,0,0,0);}}
}
typedef __attribute__((address_space(3))) const char* lds_cptr;
typedef short v4i16_t __attribute__((ext_vector_type(4)));
__device__ __forceinline__ void kload8(bf16x8*kf,lds_cptr kp){
  kf[0]=*(const __attribute__((address_space(3))) bf16x8*)(kp);      kf[1]=*(const __attribute__((address_space(3))) bf16x8*)(kp+512);
  kf[2]=*(const __attribute__((address_space(3))) bf16x8*)(kp+2048); kf[3]=*(const __attribute__((address_space(3))) bf16x8*)(kp+2560);
  kf[4]=*(const __attribute__((address_space(3))) bf16x8*)(kp+4096); kf[5]=*(const __attribute__((address_space(3))) bf16x8*)(kp+4608);
  kf[6]=*(const __attribute__((address_space(3))) bf16x8*)(kp+6144); kf[7]=*(const __attribute__((address_space(3))) bf16x8*)(kp+6656);
}
__device__ __forceinline__ void kload2(bf16x8*kf,lds_cptr kp,int j){ kf[2*j]=*(const __attribute__((address_space(3))) bf16x8*)(kp+j*2048); kf[2*j+1]=*(const __attribute__((address_space(3))) bf16x8*)(kp+j*2048+512); }
__device__ __forceinline__ s16x4 vtr(lds_cptr p){ return __builtin_bit_cast(s16x4,__builtin_amdgcn_ds_read_tr16_b64_v4i16((__attribute__((address_space(3))) v4i16_t*)p)); }
__device__ __forceinline__ float rowmax(const f32x16&p0,const f32x16&p1){
  float a=max3f(p0[0],p0[1],p1[0]),b=max3f(p0[2],p0[3],p1[1]);a=max3f(a,p1[2],p1[3]);
  #pragma unroll
  for(int r=4;r<16;r+=4){a=max3f(a,p0[r],p0[r+1]);b=max3f(b,p0[r+2],p0[r+3]);a=max3f(a,p1[r],p1[r+1]);b=max3f(b,p1[r+2],p1[r+3]);}
  const float m=max2f(a,b);
  auto rr=__builtin_amdgcn_permlane32_swap(__float_as_uint(m),__float_as_uint(m),false,false);
  return max2f(__uint_as_float(rr[0]),__uint_as_float(rr[1]));
}
__device__ __forceinline__ void pv(f32x16*o,int vb,bf16x8 pa0,bf16x8 pa1,bf16x8 pa2,bf16x8 pa3){
  #pragma unroll
  for(int d0=0;d0<2;++d0){s16x4 lo[4],hi[4];
    #pragma unroll
    for(int ks=0;ks<4;++ks){
      asm volatile("ds_read_b64_tr_b16 %0,%1 offset:%c2":"=&v"(lo[ks]):"v"(vb),"i"(d0*4096+ks*1024):"memory");
      asm volatile("ds_read_b64_tr_b16 %0,%1 offset:%c2":"=&v"(hi[ks]):"v"(vb),"i"(d0*4096+ks*1024+512):"memory");}
    asm volatile("s_waitcnt lgkmcnt(0)":::"memory");SBAR();
    #define PK(k) (bf16x8){lo[k][0],lo[k][1],lo[k][2],lo[k][3],hi[k][0],hi[k][1],hi[k][2],hi[k][3]}
    o[d0]=__builtin_amdgcn_mfma_f32_32x32x16_bf16(pa0,PK(0),o[d0],0,0,0);
    o[d0]=__builtin_amdgcn_mfma_f32_32x32x16_bf16(pa1,PK(1),o[d0],0,0,0);
    o[d0]=__builtin_amdgcn_mfma_f32_32x32x16_bf16(pa2,PK(2),o[d0],0,0,0);
    o[d0]=__builtin_amdgcn_mfma_f32_32x32x16_bf16(pa3,PK(3),o[d0],0,0,0);
    #undef PK
  }
}

#ifndef ATTN_STORE16
#define ATTN_STORE16(p,v) (*(u32x4*)(p)=(v))
#endif
template<int THRL,int MODE> __device__ __forceinline__ void attn_unit(const bf16*Qu,const bf16*__restrict__ Kh,const bf16*__restrict__ Vh,bf16*Ou,const int opitch,const int NT,const int shift,const float sink2,char*shm){
  int tid_=threadIdx.x; asm volatile("":"+v"(tid_));
  const int tid=tid_,lane=tid&63,r32=lane&31,hi=lane>>5; const int wid=__builtin_amdgcn_readfirstlane(tid>>6);
  const bf16*Qw=Qu+(long)(wid*QBLK)*DM;
  const unsigned lds0=(unsigned)(uintptr_t)shm;
  float*wsf=(float*)(shm+LDS_WS)+wid*64;
  const bf16*ksrc=Kh+(long)lane*DM+wid*8;
  const bf16*vsrc=Vh+(long)(16*(wid&3)+(lane>>2))*DM+(wid>>2)*32+(lane&3)*8;
  const unsigned kdst=lds0+LDS_K+wid*1024, vdst=lds0+LDS_V+wid*1024;
  #define DMA_K(t,slot) glds16(ksrc+(long)(t)*KVBLK*DM,(unsigned)__builtin_amdgcn_readfirstlane(kdst+(slot)))
  #define DMA_V(t,slot) glds16(vsrc+(long)(t)*KVBLK*DM,(unsigned)__builtin_amdgcn_readfirstlane(vdst+(slot)))
  const int vb0=(int)(lds0+LDS_V)+((lane>>4)&1)*32+(lane&3)*8+(4*hi+((lane&15)>>2))*64;
  const char*Kbase=shm+LDS_K; bf16x8 kf[8];
  const lds_cptr shm3=(lds_cptr)shm; const lds_cptr kp0=shm3+LDS_K+hi*1024+r32*16; const lds_cptr vp0=shm3+LDS_V+((lane>>4)&1)*32+(lane&3)*8+(4*hi+((lane&15)>>2))*64;
  DMA_K(0,0);DMA_V(0,0);DMA_K(1,SLOTB);
  bf16x8 qr[4];
  #pragma unroll
  for(int d0=0;d0<4;++d0)qr[d0]=*reinterpret_cast<const bf16x8*>(&Qw[(long)r32*DM+d0*16+hi*8]);
  float mhat=0.f,l_reg=0.f;f32x16 o[2];o[0]=f32x16{};o[1]=f32x16{};f32x16 negm=f32x16{};
  if(MODE==1){ mhat=sink2; l_reg=hi?0.f:1.f; _Pragma("unroll") for(int r=0;r<16;++r)negm[r]=-sink2; }
  asm volatile("":"+v"(negm));
  const int qrel=wid*QBLK+r32;
  #define CMASK(P0,P1,t) do{ if(MODE==0){int jb_=(t)-(NT-4); if(jb_>=0)cmask(P0,P1,jb_,qrel,hi);} else smask(P0,P1,(t),qrel,hi,shift); }while(0)
  bool resc=false;
  #define START(P0,P1) do{ const float rm=rowmax(P0,P1); resc=false; \
    if(MODE==0 || __any(rm>(float)THRL)){ const float dl=(MODE==0)?rm:__builtin_fmaxf(rm,0.f); if(MODE==1)l_reg*=__builtin_amdgcn_exp2f(-dl); mhat=fadd_s(mhat,dl); \
      _Pragma("unroll") for(int r=0;r<16;++r){P0[r]=fsub_s(P0[r],dl);P1[r]=fsub_s(P1[r],dl);} \
      _Pragma("unroll") for(int r=0;r<16;++r)negm[r]=-mhat; asm volatile("":"+v"(negm)); } \
    _Pragma("unroll") for(int r=0;r<16;++r)P0[r]=__builtin_amdgcn_exp2f(P0[r]); }while(0)
  #define RESC() do{ if(resc){ asm volatile("s_waitcnt lgkmcnt(0)":::"memory"); \
      _Pragma("unroll") for(int d_=0;d_<2;++d_) _Pragma("unroll") for(int r=0;r<16;++r)o[d_][r]*=wsf[crow(r,hi)]; } }while(0)
  f32x16 pA0,pA1,pB0,pB1;
  int sl_prev=0,sl_cur=0,sl_next=SLOTB;
  #define ROT() do{sl_prev=sl_cur;sl_cur=sl_next;sl_next=(sl_next==(NSLOT-1)*SLOTB)?0:sl_next+SLOTB;}while(0)
  DMA_K(2,2*SLOTB);
  WAIT_BAR(3);
  qkt(pA0,pA1,Kbase,qr,negm,r32,hi);asm volatile("s_nop 15\n\ts_nop 7":"+v"(pA0),"+v"(pA1));CMASK(pA0,pA1,0);
  START(pA0,pA1);
  _Pragma("unroll") for(int r=0;r<16;++r)pA1[r]=__builtin_amdgcn_exp2f(pA1[r]);
  WAIT_BAR(0);
  DMA_K(3,0);DMA_V(1,SLOTB);
  ROT();
  kload8(kf,kp0+sl_cur);
  WAIT_BAR(2);
  s16x4 vlo[8],vhi[8]; u32x4 pw0,pw1,pw2,pw3;
  #define PKW(P,B) cvtpk_s(P[B],P[B+1])
  #define PAF(k) __builtin_bit_cast(bf16x8,pw##k)
  #define VFR(i) (bf16x8){vlo[i][0],vlo[i][1],vlo[i][2],vlo[i][3],vhi[i][0],vhi[i][1],vhi[i][2],vhi[i][3]}
  #define PIN(x) asm volatile("":"+v"(x))
  #define MX3(a,b,c) __builtin_fmaxf(__builtin_fmaxf((a),(b)),(c))
  #define GAPA(MF,A0,A1,A2,A3,W0,W1,PW) do{ MF; sacc+=A0; sacc+=A1; sacc+=A2; sacc+=A3; PIN(sacc); W0; W1; PIN(PW); SBAR(); }while(0)
  #define EX(v) __builtin_amdgcn_exp2f(v)
  #define GAPB(MF,X,B) do{ MF; X[B]=EX(X[B]); X[B+1]=EX(X[B+1]); X[B+2]=EX(X[B+2]); X[B+3]=EX(X[B+3]); PIN(X); SBAR(); }while(0)
  #define VRD(i) do{ vlo[i]=vtr(vp_+(((i)>>2)*4096+((i)&3)*1024)); vhi[i]=vtr(vp_+(((i)>>2)*4096+((i)&3)*1024+512)); }while(0)
  #define KRD(G,j) do{ if(G){ kload2(kf,kp0+sl_next,j); SBAR(); } }while(0)
  #define STEP(C0,C1,P0,P1,t,GK,GV,GL) do{ SBAR(); \
    const lds_cptr vp_=vp0+sl_prev; \
    VRD(0); SBAR(); float sacc=(P0[0]+P0[1]); \
    GAPA(C0=__builtin_amdgcn_mfma_f32_32x32x16_bf16(kf[0],qr[0],negm,0,0,0), P0[2],P0[3],P0[4],P0[5],     pw0[0]=PKW(P0,0), pw0[1]=PKW(P0,2), pw0); \
    VRD(4); SBAR(); GAPA(C1=__builtin_amdgcn_mfma_f32_32x32x16_bf16(kf[1],qr[0],negm,0,0,0), P0[6],P0[7],P0[8],P0[9],     pw0[2]=PKW(P0,4), pw0[3]=PKW(P0,6), pw0); \
    VRD(1); SBAR(); GAPA(C0=__builtin_amdgcn_mfma_f32_32x32x16_bf16(kf[2],qr[1],C0,0,0,0),   P0[10],P0[11],P0[12],P0[13], pw1[0]=PKW(P0,8), pw1[1]=PKW(P0,10), pw1); \
    VRD(5); SBAR(); GAPA(C1=__builtin_amdgcn_mfma_f32_32x32x16_bf16(kf[3],qr[1],C1,0,0,0),   P0[14],P0[15],P1[0],P1[1],   pw1[2]=PKW(P0,12),pw1[3]=PKW(P0,14), pw1); \
    VRD(2); SBAR(); GAPA(C0=__builtin_amdgcn_mfma_f32_32x32x16_bf16(kf[4],qr[2],C0,0,0,0),   P1[2],P1[3],P1[4],P1[5],     pw2[0]=PKW(P1,0), pw2[1]=PKW(P1,2), pw2); \
    VRD(6); SBAR(); GAPA(C1=__builtin_amdgcn_mfma_f32_32x32x16_bf16(kf[5],qr[2],C1,0,0,0),   P1[6],P1[7],P1[8],P1[9],     pw2[2]=PKW(P1,4), pw2[3]=PKW(P1,6), pw2); \
    VRD(3); SBAR(); GAPA(C0=__builtin_amdgcn_mfma_f32_32x32x16_bf16(kf[6],qr[3],C0,0,0,0),   P1[10],P1[11],P1[12],P1[13], pw3[0]=PKW(P1,8), pw3[1]=PKW(P1,10), pw3); \
    VRD(7); SBAR(); GAPA(C1=__builtin_amdgcn_mfma_f32_32x32x16_bf16(kf[7],qr[3],C1,0,0,0),   P1[14],P1[15],0.f,0.f,       pw3[2]=PKW(P1,12),pw3[3]=PKW(P1,14), pw3); \
    l_reg+=sacc; \
    if(GK){DMA_K((t)+3,sl_cur);} if(GV){DMA_V((t)+1,sl_next);} \
    CMASK(C0,C1,t); \
    { float a=MX3(C0[0],C0[1],C1[0]),b=MX3(C0[2],C0[3],C1[1]); a=MX3(a,C1[2],C1[3]); \
      _Pragma("unroll") for(int r=4;r<16;r+=4){a=MX3(a,C0[r],C0[r+1]);b=MX3(b,C0[r+2],C0[r+3]);a=MX3(a,C1[r],C1[r+1]);b=MX3(b,C1[r+2],C1[r+3]);} \
      float rm=__builtin_fmaxf(a,b); { auto rr=__builtin_amdgcn_permlane32_swap(__float_as_uint(rm),__float_as_uint(rm),false,false); rm=__builtin_fmaxf(__uint_as_float(rr[0]),__uint_as_float(rr[1])); } \
      resc=false; \
      if(__builtin_expect(__any(rm>(float)THRL),0)){ const float dl=__builtin_fmaxf(rm,0.f); mhat+=dl; \
        _Pragma("unroll") for(int r=0;r<16;++r){C0[r]-=dl;C1[r]-=dl;} \
        _Pragma("unroll") for(int r=0;r<16;++r)negm[r]=-mhat; asm volatile("":"+v"(negm)); \
        const float f=__builtin_amdgcn_exp2f(-dl); l_reg*=f; if(hi==0)wsf[r32]=f; resc=true; } } \
    SBAR(); \
    GAPB(o[0]=__builtin_amdgcn_mfma_f32_32x32x16_bf16(PAF(0),VFR(0),o[0],0,0,0), C0,0); \
    GAPB(o[1]=__builtin_amdgcn_mfma_f32_32x32x16_bf16(PAF(0),VFR(4),o[1],0,0,0), C0,4); \
    KRD(GL,0); GAPB(o[0]=__builtin_amdgcn_mfma_f32_32x32x16_bf16(PAF(1),VFR(1),o[0],0,0,0), C0,8); \
    KRD(GL,1); GAPB(o[1]=__builtin_amdgcn_mfma_f32_32x32x16_bf16(PAF(1),VFR(5),o[1],0,0,0), C0,12); \
    KRD(GL,2); GAPB(o[0]=__builtin_amdgcn_mfma_f32_32x32x16_bf16(PAF(2),VFR(2),o[0],0,0,0), C1,0); \
    KRD(GL,3); GAPB(o[1]=__builtin_amdgcn_mfma_f32_32x32x16_bf16(PAF(2),VFR(6),o[1],0,0,0), C1,4); \
    GAPB(o[0]=__builtin_amdgcn_mfma_f32_32x32x16_bf16(PAF(3),VFR(3),o[0],0,0,0), C1,8); \
    GAPB(o[1]=__builtin_amdgcn_mfma_f32_32x32x16_bf16(PAF(3),VFR(7),o[1],0,0,0), C1,12); \
    }while(0)
  int t=1;
  #undef CMASK
  #define CMASK(P0,P1,t) do{}while(0)
  for(;t+5<NT;t+=2){
    STEP(pB0,pB1,pA0,pA1,t,true,true,true);     WAIT_BAR(2); RESC(); ROT();
    STEP(pA0,pA1,pB0,pB1,t+1,true,true,true);   WAIT_BAR(2); RESC(); ROT();
  }
  #undef CMASK
  #define CMASK(P0,P1,t) do{ if(MODE==0){int jb_=(t)-(NT-4); if(jb_>=0)cmask(P0,P1,jb_,qrel,hi);} else smask(P0,P1,(t),qrel,hi,shift); }while(0)
  #define ENDW(tt) do{ if((tt)+3<NT){WAIT_BAR(2);} else if((tt)+2<NT){WAIT_BAR(1);} else {WAIT_BAR(0);} }while(0)
  for(;t+1<NT;t+=2){
    STEP(pB0,pB1,pA0,pA1,t,(t+3<NT),(t+1<NT),(t+1<NT));       ENDW(t);   RESC(); ROT();
    STEP(pA0,pA1,pB0,pB1,t+1,(t+4<NT),(t+2<NT),(t+2<NT));     ENDW(t+1); RESC(); ROT();
  }
  STEP(pB0,pB1,pA0,pA1,NT-1,false,false,false); RESC();
  { float sacc=pB0[0]+pB0[1]; _Pragma("unroll") for(int r=2;r<16;++r)sacc+=pB0[r]; _Pragma("unroll") for(int r=0;r<16;++r)sacc+=pB1[r]; l_reg+=sacc;
    pw0=(u32x4){PKW(pB0,0),PKW(pB0,2),PKW(pB0,4),PKW(pB0,6)};pw1=(u32x4){PKW(pB0,8),PKW(pB0,10),PKW(pB0,12),PKW(pB0,14)};pw2=(u32x4){PKW(pB1,0),PKW(pB1,2),PKW(pB1,4),PKW(pB1,6)};pw3=(u32x4){PKW(pB1,8),PKW(pB1,10),PKW(pB1,12),PKW(pB1,14)};
    SBAR(); pv(o,vb0+sl_cur,PAF(0),PAF(1),PAF(2),PAF(3)); }
  #undef PKW
  #undef PAF
  #undef VFR
  #undef PIN
  #undef MX3
  #undef GAPA
  #undef GAPB
  #undef EX
  #undef VRD
  #undef KRD
  #undef STEP
  #undef ENDW
  {auto rr=__builtin_amdgcn_permlane32_swap(__float_as_uint(l_reg),__float_as_uint(l_reg),false,false);l_reg=__uint_as_float(rr[0])+__uint_as_float(rr[1]);}
  if(hi==0)wsf[32+r32]=l_reg;asm volatile("s_waitcnt lgkmcnt(0)":::"memory");
  float rli[16];
  #pragma unroll
  for(int r=0;r<16;++r)rli[r]=__builtin_amdgcn_rcpf(wsf[32+crow(r,hi)]);
  bf16*Ow=Ou+(long)(wid*QBLK)*opitch;
  { bf16*stg=(bf16*)(shm+LDS_OST)+wid*2048;
    #pragma unroll
    for(int r=0;r<16;++r){const int orow=crow(r,hi);
      #pragma unroll
      for(int d0=0;d0<2;++d0)stg[orow*64+d0*32+r32]=(bf16)(cvtpk_s(o[d0][r]*rli[r],0.f)&0xffffu);}
    asm volatile("s_waitcnt lgkmcnt(0)":::"memory");
    #pragma unroll
    for(int i=0;i<4;++i){const int row=i*8+(lane>>3),ch=lane&7; const u32x4 v=*(const u32x4*)(stg+row*64+ch*8); ATTN_STORE16(Ow+(long)row*opitch+ch*8,v);} }
  asm volatile("s_waitcnt lgkmcnt(0)\n\ts_barrier":::"memory");
  #undef DMA_K
  #undef DMA_V
  #undef CMASK
  #undef START
  #undef RESC
  #undef ROT
}
constexpr int N_LDS_V=NSLOT*SLOTB, N_LDS_WS=N_LDS_V+NSLOT*2*SLOTB, N_LDS_OST=N_LDS_WS+NW*64*4, N_LDS_BYTES=N_LDS_OST+NW*8192;
template<int THRL> __device__ __forceinline__ void attn_unit128(const bf16*Qu,const bf16*__restrict__ Kh,const bf16*__restrict__ Vh,bf16*Ou,const int opitch,const int NT,char*shm){
  constexpr int MODE=0; const int shift=0;
  int tid_=threadIdx.x; asm volatile("":"+v"(tid_));
  const int tid=tid_,lane=tid&63,r32=lane&31,hi=lane>>5; const int wid=__builtin_amdgcn_readfirstlane(tid>>6);
  const bf16*Qw=Qu+(long)(wid*QBLK)*DM;
  const unsigned lds0=(unsigned)(uintptr_t)shm;
  float*wsf=(float*)(shm+N_LDS_WS)+wid*64;
  const bf16*ksrc=Kh+(long)lane*DM+wid*8;
  const bf16*vsrc=Vh+(long)(16*(wid&3)+(lane>>2))*DM+(wid>>2)*32+(lane&3)*8;
  const unsigned kdst=lds0+LDS_K+wid*1024, vdst=lds0+N_LDS_V+wid*1024;
  #define DMA_K(t,slot) glds16(ksrc+(long)(t)*KVBLK*DM,(unsigned)__builtin_amdgcn_readfirstlane(kdst+(slot)))
  #define DMA_V(t,slot) do{ glds16(vsrc+(long)(t)*KVBLK*DM,(unsigned)__builtin_amdgcn_readfirstlane(vdst+2*(slot))); glds16(vsrc+(long)(t)*KVBLK*DM+64,(unsigned)__builtin_amdgcn_readfirstlane(vdst+2*(slot)+8192)); }while(0)
  const int vb0=(int)(lds0+N_LDS_V)+((lane>>4)&1)*32+(lane&3)*8+(4*hi+((lane&15)>>2))*64;
  const char*Kbase=shm+LDS_K; bf16x8 kf[8];
  const lds_cptr shm3=(lds_cptr)shm; const lds_cptr kp0=shm3+LDS_K+hi*1024+r32*16; const lds_cptr vp0=shm3+N_LDS_V+((lane>>4)&1)*32+(lane&3)*8+(4*hi+((lane&15)>>2))*64;
  DMA_K(0,0);DMA_V(0,0);DMA_K(1,SLOTB);
  typedef __attribute__((address_space(3))) bf16x8* lds_qptr; const lds_qptr qst=(lds_qptr)(shm3+N_LDS_OST+wid*8192)+lane;
  { bf16x8 qr[4];
  #pragma unroll
  for(int d0=0;d0<4;++d0)qr[d0]=*reinterpret_cast<const bf16x8*>(&Qw[(long)r32*DM+d0*16+hi*8]);
  #pragma unroll
  for(int d0=0;d0<4;++d0)qst[64*d0]=qr[d0]; }
  #define QF(d0) (qst[64*(d0)])
  float mhat=0.f,l_reg=0.f;f32x16 o[4],negm; { float z_; asm volatile("v_mov_b32 %0, 0":"=v"(z_));
    _Pragma("unroll") for(int r=0;r<16;++r){o[0][r]=z_;o[1][r]=z_;o[2][r]=z_;o[3][r]=z_;negm[r]=z_;} }
  asm volatile("":"+v"(negm));
  const int qrel=wid*QBLK+r32;
  #define CMASK(P0,P1,t) do{ if(MODE==0){int jb_=(t)-(NT-4); if(jb_>=0)cmask(P0,P1,jb_,qrel,hi);} else smask(P0,P1,(t),qrel,hi,shift); }while(0)
  bool resc=false;
  #define START(P0,P1) do{ const float rm=rowmax(P0,P1); resc=false; \
    if(MODE==0 || __any(rm>(float)THRL)){ const float dl=(MODE==0)?rm:__builtin_fmaxf(rm,0.f); if(MODE==1)l_reg*=__builtin_amdgcn_exp2f(-dl); mhat=fadd_s(mhat,dl); \
      _Pragma("unroll") for(int r=0;r<16;++r){P0[r]=fsub_s(P0[r],dl);P1[r]=fsub_s(P1[r],dl);} \
      _Pragma("unroll") for(int r=0;r<16;++r)negm[r]=-mhat; asm volatile("":"+v"(negm)); } \
    _Pragma("unroll") for(int r=0;r<16;++r)P0[r]=__builtin_amdgcn_exp2f(P0[r]); }while(0)
  #define RESC() do{ if(resc){ asm volatile("s_waitcnt lgkmcnt(0)":::"memory"); \
      _Pragma("unroll") for(int d_=0;d_<4;++d_) _Pragma("unroll") for(int r=0;r<16;++r)o[d_][r]*=wsf[crow(r,hi)]; } }while(0)
  f32x16 pA0,pA1,pB0,pB1;
  int sl_prev=0,sl_cur=0,sl_next=SLOTB;
  #define ROT() do{sl_prev=sl_cur;sl_cur=sl_next;sl_next=(sl_next==(NSLOT-1)*SLOTB)?0:sl_next+SLOTB;}while(0)
  DMA_K(2,2*SLOTB);
  WAIT_BAR(4);
  { bf16x8 qr[4]; _Pragma("unroll") for(int d0=0;d0<4;++d0)qr[d0]=QF(d0); qkt(pA0,pA1,Kbase,qr,negm,r32,hi); }asm volatile("s_nop 15\n\ts_nop 7":"+v"(pA0),"+v"(pA1));CMASK(pA0,pA1,0);
  START(pA0,pA1);
  _Pragma("unroll") for(int r=0;r<16;++r)pA1[r]=__builtin_amdgcn_exp2f(pA1[r]);
  WAIT_BAR(0);
  DMA_K(3,0);DMA_V(1,SLOTB);
  ROT();
  kload8(kf,kp0+sl_cur);
  WAIT_BAR(3);
  s16x4 vlo[8],vhi[8]; u32x4 pw0,pw1,pw2,pw3;
  #define PKW(P,B) cvtpk_s(P[B],P[B+1])
  #define PAF(k) __builtin_bit_cast(bf16x8,pw##k)
  #define VFR(i) (bf16x8){vlo[i][0],vlo[i][1],vlo[i][2],vlo[i][3],vhi[i][0],vhi[i][1],vhi[i][2],vhi[i][3]}
  #define PIN(x) asm volatile("":"+v"(x))
  #define MX3(a,b,c) __builtin_fmaxf(__builtin_fmaxf((a),(b)),(c))
  #define GAPA(MF,A0,A1,A2,A3,W0,W1,PW) do{ MF; sacc+=A0; sacc+=A1; sacc+=A2; sacc+=A3; PIN(sacc); W0; W1; PIN(PW); SBAR(); }while(0)
  #define EX(v) __builtin_amdgcn_exp2f(v)
  #define GAPB(MF,X,B,RD) do{ MF; X[B]=EX(X[B]); X[B+1]=EX(X[B+1]); PIN(X); RD; SBAR(); }while(0)
  #define VRD2(i) do{ vlo[i]=vtr(vp_+((2+((i)>>2))*4096+((i)&3)*1024)); vhi[i]=vtr(vp_+((2+((i)>>2))*4096+((i)&3)*1024+512)); }while(0)
  #define NORD do{}while(0)
  #define VRD(i) do{ vlo[i]=vtr(vp_+(((i)>>2)*4096+((i)&3)*1024)); vhi[i]=vtr(vp_+(((i)>>2)*4096+((i)&3)*1024+512)); }while(0)
  #define KRD(G,j) do{ if(G){ kload2(kf,kp0+sl_next,j); SBAR(); } }while(0)
  #define STEP(C0,C1,P0,P1,t,GK,GV,GL) do{ SBAR(); \
    const lds_cptr vp_=vp0+2*sl_prev; \
    bf16x8 qa_=QF(0),qb_=QF(1); VRD(0); SBAR(); float sacc=(P0[0]+P0[1]); \
    GAPA(C0=__builtin_amdgcn_mfma_f32_32x32x16_bf16(kf[0],qa_,negm,0,0,0), P0[2],P0[3],P0[4],P0[5],     pw0[0]=PKW(P0,0), pw0[1]=PKW(P0,2), pw0); \
    VRD(4); SBAR(); GAPA(C1=__builtin_amdgcn_mfma_f32_32x32x16_bf16(kf[1],qa_,negm,0,0,0), P0[6],P0[7],P0[8],P0[9],     pw0[2]=PKW(P0,4), pw0[3]=PKW(P0,6), pw0); \
    VRD(1); SBAR(); GAPA(C0=__builtin_amdgcn_mfma_f32_32x32x16_bf16(kf[2],qb_,C0,0,0,0),   P0[10],P0[11],P0[12],P0[13], pw1[0]=PKW(P0,8), pw1[1]=PKW(P0,10), pw1); \
    VRD(5); qa_=QF(2); SBAR(); GAPA(C1=__builtin_amdgcn_mfma_f32_32x32x16_bf16(kf[3],qb_,C1,0,0,0),   P0[14],P0[15],P1[0],P1[1],   pw1[2]=PKW(P0,12),pw1[3]=PKW(P0,14), pw1); \
    VRD(2); SBAR(); GAPA(C0=__builtin_amdgcn_mfma_f32_32x32x16_bf16(kf[4],qa_,C0,0,0,0),   P1[2],P1[3],P1[4],P1[5],     pw2[0]=PKW(P1,0), pw2[1]=PKW(P1,2), pw2); \
    VRD(6); qb_=QF(3); SBAR(); GAPA(C1=__builtin_amdgcn_mfma_f32_32x32x16_bf16(kf[5],qa_,C1,0,0,0),   P1[6],P1[7],P1[8],P1[9],     pw2[2]=PKW(P1,4), pw2[3]=PKW(P1,6), pw2); \
    VRD(3); SBAR(); GAPA(C0=__builtin_amdgcn_mfma_f32_32x32x16_bf16(kf[6],qb_,C0,0,0,0),   P1[10],P1[11],P1[12],P1[13], pw3[0]=PKW(P1,8), pw3[1]=PKW(P1,10), pw3); \
    VRD(7); SBAR(); GAPA(C1=__builtin_amdgcn_mfma_f32_32x32x16_bf16(kf[7],qb_,C1,0,0,0),   P1[14],P1[15],0.f,0.f,       pw3[2]=PKW(P1,12),pw3[3]=PKW(P1,14), pw3); \
    l_reg+=sacc; \
    if(GK){DMA_K((t)+3,sl_cur);} if(GV){DMA_V((t)+1,sl_next);} \
    CMASK(C0,C1,t); \
    { float a=MX3(C0[0],C0[1],C1[0]),b=MX3(C0[2],C0[3],C1[1]); a=MX3(a,C1[2],C1[3]); \
      _Pragma("unroll") for(int r=4;r<16;r+=4){a=MX3(a,C0[r],C0[r+1]);b=MX3(b,C0[r+2],C0[r+3]);a=MX3(a,C1[r],C1[r+1]);b=MX3(b,C1[r+2],C1[r+3]);} \
      float rm=__builtin_fmaxf(a,b); { auto rr=__builtin_amdgcn_permlane32_swap(__float_as_uint(rm),__float_as_uint(rm),false,false); rm=__builtin_fmaxf(__uint_as_float(rr[0]),__uint_as_float(rr[1])); } \
      resc=false; \
      if(__builtin_expect(__any(rm>(float)THRL),0)){ const float dl=__builtin_fmaxf(rm,0.f); mhat+=dl; \
        _Pragma("unroll") for(int r=0;r<16;++r){C0[r]-=dl;C1[r]-=dl;} \
        _Pragma("unroll") for(int r=0;r<16;++r)negm[r]=-mhat; asm volatile("":"+v"(negm)); \
        const float f=__builtin_amdgcn_exp2f(-dl); l_reg*=f; if(hi==0)wsf[r32]=f; resc=true; } } \
    SBAR(); \
    GAPB(o[0]=__builtin_amdgcn_mfma_f32_32x32x16_bf16(PAF(0),VFR(0),o[0],0,0,0), C0,0,  VRD2(0)); \
    GAPB(o[1]=__builtin_amdgcn_mfma_f32_32x32x16_bf16(PAF(0),VFR(4),o[1],0,0,0), C0,2,  VRD2(4)); \
    GAPB(o[0]=__builtin_amdgcn_mfma_f32_32x32x16_bf16(PAF(1),VFR(1),o[0],0,0,0), C0,4,  VRD2(1)); \
    GAPB(o[1]=__builtin_amdgcn_mfma_f32_32x32x16_bf16(PAF(1),VFR(5),o[1],0,0,0), C0,6,  VRD2(5)); \
    GAPB(o[0]=__builtin_amdgcn_mfma_f32_32x32x16_bf16(PAF(2),VFR(2),o[0],0,0,0), C0,8,  VRD2(2)); \
    GAPB(o[1]=__builtin_amdgcn_mfma_f32_32x32x16_bf16(PAF(2),VFR(6),o[1],0,0,0), C0,10, VRD2(6)); \
    GAPB(o[0]=__builtin_amdgcn_mfma_f32_32x32x16_bf16(PAF(3),VFR(3),o[0],0,0,0), C0,12, VRD2(3)); \
    GAPB(o[1]=__builtin_amdgcn_mfma_f32_32x32x16_bf16(PAF(3),VFR(7),o[1],0,0,0), C0,14, VRD2(7)); \
    GAPB(o[2]=__builtin_amdgcn_mfma_f32_32x32x16_bf16(PAF(0),VFR(0),o[2],0,0,0), C1,0,  NORD); \
    GAPB(o[3]=__builtin_amdgcn_mfma_f32_32x32x16_bf16(PAF(0),VFR(4),o[3],0,0,0), C1,2,  NORD); \
    KRD(GL,0); GAPB(o[2]=__builtin_amdgcn_mfma_f32_32x32x16_bf16(PAF(1),VFR(1),o[2],0,0,0), C1,4,  NORD); \
    KRD(GL,1); GAPB(o[3]=__builtin_amdgcn_mfma_f32_32x32x16_bf16(PAF(1),VFR(5),o[3],0,0,0), C1,6,  NORD); \
    KRD(GL,2); GAPB(o[2]=__builtin_amdgcn_mfma_f32_32x32x16_bf16(PAF(2),VFR(2),o[2],0,0,0), C1,8,  NORD); \
    KRD(GL,3); GAPB(o[3]=__builtin_amdgcn_mfma_f32_32x32x16_bf16(PAF(2),VFR(6),o[3],0,0,0), C1,10, NORD); \
    GAPB(o[2]=__builtin_amdgcn_mfma_f32_32x32x16_bf16(PAF(3),VFR(3),o[2],0,0,0), C1,12, NORD); \
    GAPB(o[3]=__builtin_amdgcn_mfma_f32_32x32x16_bf16(PAF(3),VFR(7),o[3],0,0,0), C1,14, NORD); \
    }while(0)
  int t=1;
  #undef CMASK
  #define CMASK(P0,P1,t) do{}while(0)
  for(;t+5<NT;t+=2){
    STEP(pB0,pB1,pA0,pA1,t,true,true,true);     WAIT_BAR(3); RESC(); ROT();
    STEP(pA0,pA1,pB0,pB1,t+1,true,true,true);   WAIT_BAR(3); RESC(); ROT();
  }
  #undef CMASK
  #define CMASK(P0,P1,t) do{ if(MODE==0){int jb_=(t)-(NT-4); if(jb_>=0)cmask(P0,P1,jb_,qrel,hi);} else smask(P0,P1,(t),qrel,hi,shift); }while(0)
  #define ENDW(tt) do{ if((tt)+3<NT){WAIT_BAR(3);} else if((tt)+2<NT){WAIT_BAR(2);} else {WAIT_BAR(0);} }while(0)
  for(;t+1<NT;t+=2){
    STEP(pB0,pB1,pA0,pA1,t,(t+3<NT),(t+1<NT),(t+1<NT));       ENDW(t);   RESC(); ROT();
    STEP(pA0,pA1,pB0,pB1,t+1,(t+4<NT),(t+2<NT),(t+2<NT));     ENDW(t+1); RESC(); ROT();
  }
  STEP(pB0,pB1,pA0,pA1,NT-1,false,false,false); RESC();
  { float sacc=pB0[0]+pB0[1]; _Pragma("unroll") for(int r=2;r<16;++r)sacc+=pB0[r]; _Pragma("unroll") for(int r=0;r<16;++r)sacc+=pB1[r]; l_reg+=sacc;
    pw0=(u32x4){PKW(pB0,0),PKW(pB0,2),PKW(pB0,4),PKW(pB0,6)};pw1=(u32x4){PKW(pB0,8),PKW(pB0,10),PKW(pB0,12),PKW(pB0,14)};pw2=(u32x4){PKW(pB1,0),PKW(pB1,2),PKW(pB1,4),PKW(pB1,6)};pw3=(u32x4){PKW(pB1,8),PKW(pB1,10),PKW(pB1,12),PKW(pB1,14)};
    SBAR(); pv(o,vb0+2*sl_cur,PAF(0),PAF(1),PAF(2),PAF(3)); pv(o+2,vb0+2*sl_cur+8192,PAF(0),PAF(1),PAF(2),PAF(3)); }
  #undef PKW
  #undef PAF
  #undef VFR
  #undef PIN
  #undef MX3
  #undef GAPA
  #undef GAPB
  #undef EX
  #undef VRD
  #undef VRD2
  #undef NORD
  #undef QF
  #undef KRD
  #undef STEP
  #undef ENDW
  {auto rr=__builtin_amdgcn_permlane32_swap(__float_as_uint(l_reg),__float_as_uint(l_reg),false,false);l_reg=__uint_as_float(rr[0])+__uint_as_float(rr[1]);}
  if(hi==0)wsf[32+r32]=l_reg;asm volatile("s_waitcnt lgkmcnt(0)":::"memory");
  float rli[16];
  #pragma unroll
  for(int r=0;r<16;++r)rli[r]=__builtin_amdgcn_rcpf(wsf[32+crow(r,hi)]);
  bf16*Ow=Ou+(long)(wid*QBLK)*opitch;
  { bf16*stg=(bf16*)(shm+N_LDS_OST)+wid*4096;
    #pragma unroll
    for(int r=0;r<16;++r){const int orow=crow(r,hi);
      #pragma unroll
      for(int d0=0;d0<4;++d0)stg[orow*128+d0*32+r32]=(bf16)(cvtpk_s(o[d0][r]*rli[r],0.f)&0xffffu);}
    asm volatile("s_waitcnt lgkmcnt(0)":::"memory");
    #pragma unroll
    for(int i=0;i<8;++i){const int row=i*4+(lane>>4),ch=lane&15; const u32x4 v=*(const u32x4*)(stg+row*128+ch*8); ATTN_STORE16(Ow+(long)row*opitch+ch*8,v);} }
  asm volatile("s_waitcnt lgkmcnt(0)\n\ts_barrier":::"memory");
  #undef DMA_K
  #undef DMA_V
  #undef CMASK
  #undef START
  #undef RESC
  #undef ROT
}
constexpr int ATTN_LDS_BYTES=LDS_BYTES;
#undef SBAR
#undef WAIT_BAR
}
constexpr int NWAVES = 8;
constexpr int RING_BYTES = 131072;
constexpr int TBL_OFF = 140 * 1024;
constexpr int MISC_OFF = 143 * 1024;
constexpr int LDS_BYTES = 147456;
static_assert(ROUTER_LDS <= TBL_OFF && attn_body::ATTN_LDS_BYTES <= RING_BYTES && attn_body::N_LDS_BYTES <= TBL_OFF, "LDS map");
constexpr int CW_BAR = 4096;
constexpr int MAX_LAUNCHES = 12;

#define GAS __attribute__((address_space(1)))
#define LAS __attribute__((address_space(3)))
typedef GAS unsigned gu32;
#define RLX_AGENT __ATOMIC_RELAXED, __HIP_MEMORY_SCOPE_AGENT
#define XB_TMO      128
#define XB_XCNT(j)  (256  + 64 * (j))
#define XB_XSUB(j)  (1280 + 64 * (j))
#define XB_XGEN(j)  (2304 + 64 * (j))
#define XB_TOP      3328
#define XB_TOPGEN   3392
#define XCD_BAR_WORDS 3456
#define XB_SPIN_CAP (1u << 18)

__device__ __forceinline__ unsigned xb_ld(unsigned* p)              { return __hip_atomic_load(p, __ATOMIC_RELAXED, __HIP_MEMORY_SCOPE_AGENT); }
__device__ __forceinline__ unsigned xb_add(unsigned* p, unsigned v) { return __hip_atomic_fetch_add(p, v, __ATOMIC_RELAXED, __HIP_MEMORY_SCOPE_AGENT); }
__device__ __forceinline__ unsigned xb_xcc_id() { return (unsigned)__builtin_amdgcn_s_getreg((3 << 11) | 20) & 0xFu; }
#define XB_SPIN(cond, bar) do { unsigned _sp = 0; while (cond) { __builtin_amdgcn_s_sleep(1); \
    if ((++_sp & 255u) == 0u) { if (xb_ld(&(bar)[XB_TMO])) break; if (_sp > XB_SPIN_CAP) { atomicAdd(&(bar)[XB_TMO], 1u); break; } } } } while (0)

struct XcdBarrier {
    unsigned* bar; unsigned x;
    volatile LAS unsigned* st;
};

__device__ __forceinline__ XcdBarrier xcd_barrier_post(unsigned* bar, volatile LAS unsigned* st) {
    XcdBarrier b; b.bar = bar; b.x = xb_xcc_id(); b.st = st;
    if (threadIdx.x == 0) (void)xb_add(&bar[XB_XCNT(b.x)], 1u);
    return b;
}
__device__ __forceinline__ void xcd_barrier_complete(unsigned* bar, unsigned x, unsigned& nloc, unsigned& nx) {
    const unsigned G = gridDim.x * gridDim.y * gridDim.z;
    unsigned sum, cnt, mine, sp = 0u;
    for (;;) {
        sum = 0u; cnt = 0u; mine = 0u;
#pragma unroll
        for (unsigned j = 0; j < 16; ++j) { const unsigned c = xb_ld(&bar[XB_XCNT(j)]); sum += c; cnt += (c > 0u) ? 1u : 0u; mine = (j == x) ? c : mine; }
        if (sum == G) break;
        __builtin_amdgcn_s_sleep(1);
        if ((++sp & 255u) == 0u) { if (xb_ld(&bar[XB_TMO])) break; if (sp > XB_SPIN_CAP) { atomicAdd(&bar[XB_TMO], 1u); break; } }
    }
    nloc = mine > 0u ? mine : 1u; nx = cnt > 0u ? cnt : 1u;
}

__device__ __forceinline__ void xcd_barrier(const XcdBarrier& b) {
    asm volatile("s_waitcnt vmcnt(0)" ::: "memory");
    __syncthreads();
    if (threadIdx.x == 0) {
        unsigned* bar = b.bar;
        __builtin_amdgcn_s_waitcnt(0);
        unsigned nloc = b.st[0], nx = b.st[1];
        if (nloc == 0u) { xcd_barrier_complete(bar, b.x, nloc, nx); b.st[0] = nloc; b.st[1] = nx; }
        const unsigned old = xb_add(&bar[XB_XSUB(b.x)], 1u);
        const unsigned gen = old / nloc;
        if (old + 1u == (gen + 1u) * nloc) {
            __builtin_amdgcn_fence(__ATOMIC_RELEASE, "agent");
            asm volatile("s_waitcnt vmcnt(0)" ::: "memory");
            const unsigned og = xb_add(&bar[XB_TOP], 1u);
            const unsigned tg = og / nx;
            if (og + 1u == (tg + 1u) * nx) xb_add(&bar[XB_TOPGEN], 1u);
            else XB_SPIN(xb_ld(&bar[XB_TOPGEN]) == tg, bar);
            __builtin_amdgcn_fence(__ATOMIC_ACQUIRE, "agent");
            xb_add(&bar[XB_XGEN(b.x)], 1u);
            asm volatile("s_waitcnt vmcnt(0)" ::: "memory");
        } else {
            XB_SPIN(xb_ld(&bar[XB_XGEN(b.x)]) == gen, bar);
            __builtin_amdgcn_fence(__ATOMIC_ACQUIRE, "agent");
            asm volatile("s_waitcnt vmcnt(0)" ::: "memory");
        }
    }
    __syncthreads();
}


static_assert((CW_BAR + MAX_LAUNCHES * XCD_BAR_WORDS) * 4 <= (int)CTL_ZERO_BYTES, "barrier words inside the memset region");

__device__ __forceinline__ void convert_w2_dynamic(const Params& p, volatile LAS unsigned* MISC, int maxchunks) {
    const int tid = threadIdx.x, lane = tid & 63, wave = tid >> 6; unsigned* cur = (unsigned*)(p.ws + WS_CTL) + CW_W2CUR;
    constexpr int NDYN = NEXP * T8_W2 - PREP_W2_ITEMS;
    for (int n = 0; maxchunks < 0 || n < maxchunks; ++n) {
        __syncthreads();
        if (tid == 0) MISC[16] = atomicAdd(cur, (unsigned)W2_CHUNK);
        __syncthreads();
        const int start = (int)MISC[16]; if (start >= NDYN) break;
        const int lo = T8_W2_START + PREP_W2_ITEMS + start, hi = T8_W2_START + PREP_W2_ITEMS + (start + W2_CHUNK < NDYN ? start + W2_CHUNK : NDYN);
        transpose8_items(p, lo, hi, wave, 8, lane);
    }
}
__device__ __forceinline__ void phase_inproj(const Params& p, LAS unsigned char* lds, int G, int bid) {
    pg8::Gemm g{p.ws + WS_H1, p.ws + WS_WIN, DM * 2, 0};
    pg8::StaticOrder S; S.init(NTOK, NPROJ, G, bid);
    pg8::EpiProj E{(bf16_t*)(p.ws + WS_PROJ), (const float*)(p.ws + WS_BINP), (const float*)(p.ws + WS_ROPE), (const float*)(p.ws + WS_ROPE) + (size_t)NTOK * 32};
    pg8::gemm_phase<pg8::EpiProj, pg8::StaticOrder, false, false>(lds, g, S, E);
    if (S.nwg % G != 0 && bid >= S.nwg % G) convert_w2_dynamic(p, (volatile LAS unsigned*)(lds + MISC_OFF), 1);
}
__device__ __forceinline__ void phase_attn(const Params& p, char* lds, int G, int bid) {
    const int vcu = (G % 8 == 0) ? (bid % 8) * (G / 8) + bid / 8 : bid;
    const attn_body::bf16* proj = (const attn_body::bf16*)(p.ws + WS_PROJ);
    for (int v = vcu; v < 256; v += G) {
        const int bhm = v >> 4, s = v & 15, b = bhm >> 3, hm = bhm & 7;
        const attn_body::bf16* rowb = proj + (size_t)b * SEQ * NPROJ;
#pragma unroll 1
        for (int i = 0; i < 2; ++i) { const int qb = i ? 31 - s : s;
            attn_body::attn_unit128<8>(rowb + (size_t)qb * 256 * NPROJ + PC_QD + hm * 64, rowb + PC_KD + hm * 64, rowb + PC_VD + (hm >> 1) * 128,
                                       (attn_body::bf16*)(p.ws + WS_OV) + ((size_t)b * SEQ + qb * 256) * DM + hm * 128, DM, 4 * (qb + 1), lds); }
    }
#pragma unroll 1
    for (int w = vcu; w < 512; w += G) {
        const int b = w >> 8, hq = (w >> 5) & 7, qb = w & 31, shift = qb ? 128 : 0;
        const attn_body::bf16* rowb = proj + (size_t)b * SEQ * NPROJ; const size_t krow = (size_t)(qb * 256 - shift) * NPROJ;
        attn_body::attn_unit<8, 1>(rowb + (size_t)qb * 256 * NPROJ + PC_QA + hq * 64, rowb + krow + PC_KA + (hq >> 2) * 64, rowb + krow + PC_VA + (hq >> 2) * 64,
                                   (attn_body::bf16*)(p.ws + WS_MIXED) + ((size_t)b * SEQ + qb * 256) * DM + hq * 64, DM, qb ? 6 : 4, shift, p.sinks[hq] * LOG2E, lds);
    }
}
__device__ __forceinline__ void phase_outproj(const Params& p, LAS unsigned char* lds, int G, int bid) {
    pg8::Gemm g{p.ws + WS_MIXED, p.ws + WS_WOUT, DM * 2, 0};
    pg8::StaticOrder S; S.init(NTOK, DM, G, bid);
    pg8::EpiX1 E{p.x, (const float*)(p.ws + WS_MOD), p.b_out, (float*)(p.ws + WS_X1), (float*)(p.ws + WS_PSUM)};
    pg8::gemm_phase<pg8::EpiX1, pg8::StaticOrder, false, false>(lds, g, S, E);
}
__device__ __forceinline__ void build_tile_table(const Params& p, LAS unsigned char* lds) {
    LAS int* tb = (LAS int*)(lds + TBL_OFF); LAS int* cn = (LAS int*)(lds + TBL_OFF + 256);
    const unsigned* cnt = (const unsigned*)(p.ws + WS_CTL) + CW_CNT;
    __syncthreads();
    if (threadIdx.x == 0) { int a = 0; for (int e = 0; e < NEXP; ++e) { const int c = (int)__hip_atomic_load(cnt + e, RLX_AGENT); tb[e] = a; cn[e] = c; a += (c + 255) >> 8; } tb[NEXP] = a; }
    __syncthreads();
}
__device__ __forceinline__ void phase_gemm1(const Params& p, LAS unsigned char* lds, int G, int bid) {
    build_tile_table(p, lds);
    pg8::Gemm g{p.ws + WS_H2, p.ws + WS_W1, DM, (size_t)2 * DFF * DM};
    pg8::GroupedOrder S; S.init((const LAS int*)(lds + TBL_OFF), (const LAS int*)(lds + TBL_OFF + 256), (const int*)(p.ws + WS_LIST), 2 * DFF / 256, G, bid);
    pg8::EpiSwiglu E{p.b1, p.ws + WS_ACT};
    pg8::gemm_phase<pg8::EpiSwiglu, pg8::GroupedOrder, true, true>(lds, g, S, E);
    convert_w2_dynamic(p, (volatile LAS unsigned*)(lds + MISC_OFF), -1);
}
__device__ __forceinline__ void phase_gemm2(const Params& p, LAS unsigned char* lds, int G, int bid) {
    build_tile_table(p, lds);
    pg8::Gemm g{p.ws + WS_ACT, p.ws + WS_W2, DFF, (size_t)DM * DFF};
    pg8::GroupedOrder S; S.init((const LAS int*)(lds + TBL_OFF), (const LAS int*)(lds + TBL_OFF + 256), (const int*)(p.ws + WS_LIST), DM / 256, G, bid);
    pg8::EpiY E{p.b2, (bf16_t*)(p.ws + WS_Y)};
    pg8::gemm_phase<pg8::EpiY, pg8::GroupedOrder, false, true>(lds, g, S, E);
}

#ifndef TIME_PHASE
#define TIME_PHASE -1
#endif
#ifndef REPEAT_PHASE
#define REPEAT_PHASE -1
#endif
constexpr int NPHASE = 10;
struct Args { Params p; int ph_lo, ph_hi, li, pad; };
__global__ void __launch_bounds__(NWAVES * 64, 2) mega(Args args) {
    extern __shared__ __attribute__((aligned(16))) unsigned char lds[];
    const Params& p = args.p;
    LAS unsigned char* L = (LAS unsigned char*)lds;
    volatile LAS unsigned* MISC = (volatile LAS unsigned*)(L + MISC_OFF);
    const int tid = threadIdx.x, G = gridDim.x, bid = blockIdx.x;
    for (int u = tid; u < (LDS_BYTES - MISC_OFF) / 4; u += NWAVES * 64) ((LAS unsigned*)(L + MISC_OFF))[u] = 0u;
    __syncthreads();
    XcdBarrier bar = xcd_barrier_post((unsigned*)(p.ws + WS_CTL) + CW_BAR + args.li * XCD_BAR_WORDS, MISC + 8);
    const int lo = args.ph_lo, hi = args.ph_hi;
#ifndef CMASKP
#define CMASKP 0x3ff
#endif
#define IN(k) (((CMASKP >> (k)) & 1) && lo <= (k) && (k) < hi)
#define SEAM(k) do { if (IN(k) && IN((k) + 1)) xcd_barrier(bar); TSTAMP(tp1_, k); } while (0)
    unsigned long long tp0_ = 0, tp1_ = 0;
#define TSTAMP(var, k) do { if (TIME_PHASE == (k) && bid == 0 && tid == 0) var = __builtin_amdgcn_s_memrealtime(); } while (0)
#define RUNPH(k, call) do { if (IN(k)) { TSTAMP(tp0_, k); call; if (REPEAT_PHASE == (k)) { xcd_barrier(bar); call; } } } while (0)
    RUNPH(0, phase_prep(p, bid, G, (float*)lds)); SEAM(0);
    RUNPH(1, phase_h1(p, bid, G)); SEAM(1);
    RUNPH(2, phase_inproj(p, L, G, bid)); SEAM(2);
    RUNPH(3, phase_attn(p, (char*)lds, G, bid)); SEAM(3);
    RUNPH(4, phase_combine(p, bid, G)); SEAM(4);
    RUNPH(5, phase_outproj(p, L, G, bid)); SEAM(5);
    if (IN(6)) { TSTAMP(tp0_, 6); phase_router(p, bid, G, lds);
        if (REPEAT_PHASE == 6) { xcd_barrier(bar); if (bid == 0 && tid < 32) ((unsigned*)(p.ws + WS_CTL))[CW_CNT + tid] = 0u; xcd_barrier(bar); phase_router(p, bid, G, lds); } } SEAM(6);
    RUNPH(7, phase_gemm1(p, L, G, bid)); SEAM(7);
    RUNPH(8, phase_gemm2(p, L, G, bid)); SEAM(8);
    RUNPH(9, phase_final(p, bid, G));
    TSTAMP(tp1_, 9);
    if (TIME_PHASE >= 0 && bid == 0 && tid == 0) { const unsigned long long tgt = __builtin_amdgcn_s_memrealtime() + 10ull * (tp1_ - tp0_); while (__builtin_amdgcn_s_memrealtime() < tgt) __builtin_amdgcn_s_sleep(8); }
    if (REPEAT_PHASE == 99) { for (int i = 0; i < 10; ++i) xcd_barrier(bar); }
#undef RUNPH
#undef IN
#undef SEAM
}

template <class Epi>
__global__ __launch_bounds__(256) void ngemm(const bf16_t* __restrict__ A, const bf16_t* __restrict__ Bt, int K, const int* __restrict__ rowmap,
                                             const int* __restrict__ tiles, size_t bstride, Epi epi) {
    __shared__ __attribute__((aligned(16))) bf16_t sA[64][40];
    __shared__ __attribute__((aligned(16))) bf16_t sB[64][40];
    const int bm = blockIdx.y * 64, bn = blockIdx.x * 64, tid = threadIdx.x, lane = tid & 63, w = tid >> 6, wr = w >> 1, wc = w & 1, fr = lane & 15, quad = lane >> 4;
    int expert = 0;
    if (tiles) { if (bm / 256 >= tiles[0]) return; expert = tiles[16 + bm / 256]; }
    const bf16_t* Bb = Bt + (size_t)expert * bstride;
    const int lr = tid >> 2, lc = (tid & 3) * 8;
    const int arow = rowmap ? rowmap[bm + lr] : bm + lr;
    const bf16_t* ap = A + (size_t)arow * K + lc; const bf16_t* bp = Bb + (size_t)(bn + lr) * K + lc;
    f32x4 acc[2][2];
#pragma unroll
    for (int i = 0; i < 2; ++i)
#pragma unroll
        for (int j = 0; j < 2; ++j) acc[i][j] = (f32x4){0.f, 0.f, 0.f, 0.f};
    for (int k0 = 0; k0 < K; k0 += 32) {
        *(u32x4*)&sA[lr][lc] = *(const u32x4*)(ap + k0); *(u32x4*)&sB[lr][lc] = *(const u32x4*)(bp + k0);
        __syncthreads();
        bf16x8 a[2], b[2];
#pragma unroll
        for (int i = 0; i < 2; ++i) { a[i] = *(const bf16x8*)&sA[wr * 32 + i * 16 + fr][quad * 8]; b[i] = *(const bf16x8*)&sB[wc * 32 + i * 16 + fr][quad * 8]; }
#pragma unroll
        for (int i = 0; i < 2; ++i)
#pragma unroll
            for (int j = 0; j < 2; ++j) acc[i][j] = __builtin_amdgcn_mfma_f32_16x16x32_bf16(a[i], b[j], acc[i][j], 0, 0, 0);
        __syncthreads();
    }
#pragma unroll
    for (int i = 0; i < 2; ++i)
#pragma unroll
        for (int j = 0; j < 2; ++j)
#pragma unroll
            for (int r = 0; r < 4; ++r) epi(bm + wr * 32 + i * 16 + quad * 4 + r, bn + wc * 32 + j * 16 + fr, acc[i][j][r], expert);
}
struct EpiProjN {
    const float* bias; const float* ropec; const float* ropes; bf16_t* out;
    __device__ __forceinline__ void operator()(int row, int col, float v, int) const {
        v += bias[col];
        const float other = __shfl_xor(v, 1);
        if (col < PC_ROPE_END) { const int f = (col & 63) >> 1; const float c = ropec[row * 32 + f], s = ropes[row * 32 + f];
            v = (col & 1) ? (v * c + other * s) : (v * c - other * s);
            if (col < PC_KA || (col >= PC_QD && col < PC_KD)) v *= C2; }
        out[(size_t)row * NPROJ + col] = (bf16_t)f2bf(v);
    }
};
struct EpiX1N {
    const float* x; const float* mod; const float* bias; float* out;
    __device__ __forceinline__ void operator()(int row, int col, float v, int) const {
        const int b = row / SEQ; out[(size_t)row * DM + col] = x[(size_t)row * DM + col] + mod[b * (NMOD * DM) + 2 * DM + col] * (v + bias[col]);
    }
};
struct EpiSwigluN {
    const float* b1; bf16_t* act;
    __device__ __forceinline__ void operator()(int row, int col, float v, int e) const {
        v += b1[(size_t)e * 2 * DFF + col];
        const float other = __shfl_xor(v, 1);
        if (!(col & 1)) { const float g = fminf(v, 7.0f), l = fminf(fmaxf(other, -7.0f), 7.0f);
            act[(size_t)row * DFF + (col >> 1)] = (bf16_t)f2bf(g / (1.0f + __expf(-1.702f * g)) * (l + 1.0f)); }
    }
};
struct EpiYN {
    const float* b2; bf16_t* y;
    __device__ __forceinline__ void operator()(int row, int col, float v, int e) const { y[(size_t)row * DM + col] = (bf16_t)f2bf(v + b2[(size_t)e * DM + col]); }
};

template <int MODE>
__global__ __launch_bounds__(64) void nattn(const bf16_t* __restrict__ proj, bf16_t* __restrict__ out, const float* __restrict__ sinks) {
    const int lane = threadIdx.x, row = blockIdx.x * 64 + lane, t = row % SEQ, rowb = row - t, t0 = (blockIdx.x * 64) % SEQ, hd = blockIdx.y;
    int qcol, kcol, vcol, ocol, opitch;
    if (MODE == 0) { const int hm = hd >> 1, half = hd & 1; qcol = PC_QD + hm * 64; kcol = PC_KD + hm * 64; vcol = PC_VD + (hm >> 1) * 128 + half * 64; ocol = hd * 64; opitch = DM; }
    else { qcol = PC_QA + hd * 64; kcol = PC_KA + (hd >> 2) * 64; vcol = PC_VA + (hd >> 2) * 64; ocol = hd * 64; opitch = DM; }
    float q[64], o[64];
#pragma unroll
    for (int i = 0; i < 8; ++i) { const u32x4 w = *(const u32x4*)(proj + (size_t)row * NPROJ + qcol + i * 8);
#pragma unroll
        for (int j = 0; j < 4; ++j) { q[i * 8 + 2 * j] = bflo(w[j]); q[i * 8 + 2 * j + 1] = bfhi(w[j]); } }
#pragma unroll
    for (int i = 0; i < 64; ++i) o[i] = 0.f;
    float m, l;
    if (MODE == 1) { m = sinks[hd] * LOG2E; l = 1.0f; } else { m = -INFINITY; l = 0.f; }
    const int jlo = MODE == 1 ? (t0 - 127 < 0 ? 0 : t0 - 127) : 0, jhi = t0 + 63;
    for (int j = jlo; j <= jhi; ++j) {
        const bf16_t* kr = proj + (size_t)(rowb + j) * NPROJ + kcol; const bf16_t* vr = proj + (size_t)(rowb + j) * NPROJ + vcol;
        float s = 0.f;
#pragma unroll
        for (int i = 0; i < 8; ++i) { const u32x4 w = *(const u32x4*)(kr + i * 8);
#pragma unroll
            for (int jj = 0; jj < 4; ++jj) { s += q[i * 8 + 2 * jj] * bflo(w[jj]); s += q[i * 8 + 2 * jj + 1] * bfhi(w[jj]); } }
        const bool vis = (j <= t) && (MODE == 0 || (t - j) < 128);
        if (!vis) s = -INFINITY;
        const float mn = fmaxf(m, s);
        if (mn == -INFINITY) continue;
        const float alpha = exp2f(m - mn), pj = exp2f(s - mn);
        l = l * alpha + pj; m = mn;
#pragma unroll
        for (int i = 0; i < 8; ++i) { const u32x4 w = *(const u32x4*)(vr + i * 8);
#pragma unroll
            for (int jj = 0; jj < 4; ++jj) { o[i * 8 + 2 * jj] = o[i * 8 + 2 * jj] * alpha + pj * bflo(w[jj]); o[i * 8 + 2 * jj + 1] = o[i * 8 + 2 * jj + 1] * alpha + pj * bfhi(w[jj]); } }
    }
    const float rl = 1.0f / l;
#pragma unroll
    for (int i = 0; i < 8; ++i) { u32x4 w;
#pragma unroll
        for (int jj = 0; jj < 4; ++jj) w[jj] = pk2(o[i * 8 + 2 * jj] * rl, o[i * 8 + 2 * jj + 1] * rl);
        *(u32x4*)(out + (size_t)row * opitch + ocol + i * 8) = w; }
}

__global__ void k_tiles(Params p) {
    const unsigned* cnt = (const unsigned*)(p.ws + WS_CTL) + CW_CNT; int* tl = (int*)(p.ws + WS_TILES); int* rowmap = (int*)(p.ws + WS_ROWMAP); const int* list = (const int*)(p.ws + WS_LIST);
    __shared__ int tb[33];
    if (threadIdx.x == 0) { int a = 0; for (int e = 0; e < 32; ++e) { tb[e] = a; a += (int)((cnt[e] + 255u) >> 8); } tb[32] = a; tl[0] = a; }
    __syncthreads();
    for (int t = blockIdx.x; t < tb[32]; t += gridDim.x) {
        int e = 0; while (t >= tb[e + 1]) ++e;
        const int mt = t - tb[e];
        if (threadIdx.x == 0) { tl[16 + t] = e; tl[512 + t] = mt; }
        for (int r = threadIdx.x; r < 256; r += blockDim.x) { const int pos = mt * 256 + r; rowmap[t * 256 + r] = pos < (int)cnt[e] ? list[e * NTOK + pos] : 0; }
    }
}


#ifndef FAST_MASK
#define FAST_MASK 0x3ff
#endif
#ifndef SINGLE
#define SINGLE 1
#endif
extern "C" void kernel_launch(void* const* d_in, const int* in_sizes, int n_in, void* d_out, int out_size, void* d_ws, size_t ws_size, hipStream_t stream) {
    static int grid = 0;
    if (grid == 0) {
        if (n_in != 24 || in_sizes[0] != NTOK * DM || out_size != NTOK * DM || ws_size < WS_END) { fprintf(stderr, "kernel_launch: unexpected shapes (n_in %d in0 %d out %d ws %zu)\n", n_in, n_in > 0 ? in_sizes[0] : -1, out_size, ws_size); grid = -1; return; }
        int dev = 0, cus = 0, per_cu = 0;
        if (hipGetDevice(&dev) != hipSuccess || hipDeviceGetAttribute(&cus, hipDeviceAttributeMultiprocessorCount, dev) != hipSuccess) { fprintf(stderr, "kernel_launch: device query failed\n"); grid = -1; return; }
        if (hipFuncSetAttribute((const void*)mega, hipFuncAttributeMaxDynamicSharedMemorySize, LDS_BYTES) != hipSuccess) { fprintf(stderr, "kernel_launch: hipFuncSetAttribute(mega) failed\n"); grid = -1; return; }
        if (hipOccupancyMaxActiveBlocksPerMultiprocessor(&per_cu, (const void*)mega, NWAVES * 64, LDS_BYTES) != hipSuccess || per_cu < 1) { fprintf(stderr, "kernel_launch: occupancy query says %d blocks per CU\n", per_cu); }
        (void)hipGetLastError();
        grid = cus;
    }
    if (grid < 0) return;
    Params p{};
    p.x = (const float*)d_in[0]; p.c = (const float*)d_in[1]; p.pos = (const int*)d_in[2]; p.w_ada = (const float*)d_in[3]; p.b_ada = (const float*)d_in[4]; p.g_mix = (const float*)d_in[5];
    p.w_in = (const float*)d_in[6]; p.b_in = (const float*)d_in[7]; p.sinks = (const float*)d_in[8]; p.lq1 = (const float*)d_in[9]; p.lk1 = (const float*)d_in[10]; p.lq2 = (const float*)d_in[11];
    p.lk2 = (const float*)d_in[12]; p.g_subln = (const float*)d_in[13]; p.w_out = (const float*)d_in[14]; p.b_out = (const float*)d_in[15]; p.g_ffn = (const float*)d_in[16];
    p.w_router = (const float*)d_in[17]; p.b_router = (const float*)d_in[18]; p.w1 = (const float*)d_in[19]; p.b1 = (const float*)d_in[20]; p.w2 = (const float*)d_in[21]; p.b2 = (const float*)d_in[22];
    p.g_final = (const float*)d_in[23]; p.out = (float*)d_out; p.ws = (unsigned char*)d_ws;
    unsigned char* ws = p.ws;
    (void)hipMemsetAsync(ws + WS_CTL, 0, CTL_ZERO_BYTES, stream);
    int li = 0;
    auto launch_mega = [&](int lo, int hi) { Args a{}; a.p = p; a.ph_lo = lo; a.ph_hi = hi; a.li = li++; hipLaunchKernelGGL(mega, dim3(grid), dim3(NWAVES * 64), LDS_BYTES, stream, a); };
    if (FAST_MASK == 0x3ff && SINGLE) { launch_mega(0, NPHASE); return; }
    bool tiles_done = false;
    for (int k = 0; k < NPHASE; ++k) {
        if ((FAST_MASK >> k) & 1) { launch_mega(k, k + 1); continue; }
        if ((k == 7 || k == 8) && !tiles_done) { hipLaunchKernelGGL(k_tiles, dim3(MAXTILES), dim3(256), 0, stream, p); tiles_done = true; }
        switch (k) {
        case 2: { EpiProjN e{(const float*)(ws + WS_BINP), (const float*)(ws + WS_ROPE), (const float*)(ws + WS_ROPE) + (size_t)NTOK * 32, (bf16_t*)(ws + WS_PROJ)};
            hipLaunchKernelGGL(ngemm<EpiProjN>, dim3(NPROJ / 64, NTOK / 64), dim3(256), 0, stream, (const bf16_t*)(ws + WS_H1), (const bf16_t*)(ws + WS_WIN), DM, (const int*)nullptr, (const int*)nullptr, (size_t)0, e); } break;
        case 3: hipLaunchKernelGGL(nattn<1>, dim3(NTOK / 64, 8), dim3(64), 0, stream, (const bf16_t*)(ws + WS_PROJ), (bf16_t*)(ws + WS_MIXED), p.sinks);
            hipLaunchKernelGGL(nattn<0>, dim3(NTOK / 64, 16), dim3(64), 0, stream, (const bf16_t*)(ws + WS_PROJ), (bf16_t*)(ws + WS_OV), p.sinks); break;
        case 5: { EpiX1N e{p.x, (const float*)(ws + WS_MOD), p.b_out, (float*)(ws + WS_X1)};
            hipLaunchKernelGGL(ngemm<EpiX1N>, dim3(DM / 64, NTOK / 64), dim3(256), 0, stream, (const bf16_t*)(ws + WS_MIXED), (const bf16_t*)(ws + WS_WOUT), DM, (const int*)nullptr, (const int*)nullptr, (size_t)0, e); } break;
        case 7: { EpiSwigluN e{p.b1, (bf16_t*)(ws + WS_ACT)};
            hipLaunchKernelGGL(ngemm<EpiSwigluN>, dim3(2 * DFF / 64, MAXROWS / 64), dim3(256), 0, stream, (const bf16_t*)(ws + WS_H2), (const bf16_t*)(ws + WS_W1), DM, (const int*)(ws + WS_ROWMAP), (const int*)(ws + WS_TILES), (size_t)2 * DFF * DM, e); } break;
        case 8: { EpiYN e{p.b2, (bf16_t*)(ws + WS_Y)};
            hipLaunchKernelGGL(ngemm<EpiYN>, dim3(DM / 64, MAXROWS / 64), dim3(256), 0, stream, (const bf16_t*)(ws + WS_ACT), (const bf16_t*)(ws + WS_W2), DFF, (const int*)nullptr, (const int*)(ws + WS_TILES), (size_t)DM * DFF, e); } break;
        default: fprintf(stderr, "kernel_launch: phase %d has no naive form\n", k); break;
        }
    }
}
```
